# Optimizing an MI355X kernel written in HIP

```python
import math
import jax, jax.numpy as jnp
from jax import lax
import numpy as np

D_MODEL = 1024
BATCH = 32
SEQ = 2048
DEPTH = 2

CTX_LEN = 256
GRID_W = 64
EPS = 1e-6
ROPE_BASE = 10000.0
Q_BLOCK = 128

DIFF_HEADS = 4
DIFF_DH = 64
DIFF_SCALE = DIFF_DH ** -0.5
MLA_HEADS = 4
MLA_Q_LORA = 256
MLA_KV_LORA = 128
MLA_NOPE = 128
MLA_ROPE = 64
MLA_V = 128
MLA_SCALE = (MLA_NOPE + MLA_ROPE) ** -0.5
EVEN_IN_SIZES = (DIFF_HEADS * 2 * DIFF_DH, DIFF_HEADS * 2 * DIFF_DH, DIFF_HEADS * 2 * DIFF_DH,
                 MLA_Q_LORA, MLA_KV_LORA, MLA_ROPE)
EVEN_IN_WIDTH = sum(EVEN_IN_SIZES)
EVEN_OUT_WIDTH = DIFF_HEADS * 2 * DIFF_DH + MLA_HEADS * MLA_V
NA_HEADS = 16
NA_DH = D_MODEL // NA_HEADS
NA_SCALE = NA_DH ** -0.5
WIN_ROWS = 8
WIN_COLS = 16
Q_COLS = 16
N_EXPERTS = 32
TOP_K = 4
D_FF = 1024
SWIGLU_ALPHA = 1.702
SWIGLU_LIMIT = 7.0
EXPERT_BLOCK = 256

N_EVEN = (DEPTH + 1) // 2
N_ODD = DEPTH // 2

kernel_name = 'hybrid_diffattn_mla_natten_moe_dit'


def rmsnorm(x, g):
    xf = x.astype(jnp.float32)
    y = xf * lax.rsqrt(jnp.mean(xf * xf, axis=-1, keepdims=True) + EPS) * g.astype(jnp.float32)
    return y.astype(x.dtype)


def modulate(h, shift, scale):
    return h * (1.0 + scale) + shift


def rope_1d(x, pos):
    d = x.shape[-1]
    half = d // 2
    inv = ROPE_BASE ** (-jnp.arange(half, dtype=jnp.float32) * 2.0 / d)
    ang = pos.astype(jnp.float32)[:, None] * inv[None, :]
    cos = jnp.cos(ang)[None, :, None, :]
    sin = jnp.sin(ang)[None, :, None, :]
    xf = x.astype(jnp.float32)
    x1, x2 = xf[..., :half], xf[..., half:]
    return jnp.concatenate([x1 * cos - x2 * sin, x2 * cos + x1 * sin], axis=-1).astype(x.dtype)


def axial_rope(x, row, col):
    half = x.shape[-1] // 2
    return jnp.concatenate([rope_1d(x[..., :half], row), rope_1d(x[..., half:], col)], axis=-1)


def _probs(q, k, scale):
    s = jnp.einsum('bqhd,bkhd->bhqk', q, k).astype(jnp.float32) * scale
    return jax.nn.softmax(s, axis=-1)


def softmax_attention(q, k, v, scale):
    p = _probs(q, k, scale).astype(v.dtype)
    return jnp.einsum('bhqk,bkhe->bqhe', p, v)


def diff_attention(q1, q2, k1, k2, v, lam, scale):
    a = _probs(q1, k1, scale) - lam * _probs(q2, k2, scale)
    return jnp.einsum('bhqk,bkhe->bqhe', a.astype(v.dtype), v)


def sweep_query_blocks(fn, *qs):
    B, S = qs[0].shape[:2]
    nb = S // Q_BLOCK
    to_blocks = lambda t: jnp.moveaxis(t.reshape(B, nb, Q_BLOCK, *t.shape[2:]), 1, 0)
    out = lax.map(lambda blk: fn(*blk), tuple(to_blocks(t) for t in qs))
    from_blocks = lambda t: jnp.moveaxis(t, 0, 1).reshape(B, S, *t.shape[3:])
    return tuple(from_blocks(t) for t in out)


def even_project(h, pos, w_in, q_norm_g, w_qb, kv_norm_g, w_kvb):
    Bn, L, _ = h.shape
    cuts = [int(s) for s in np.cumsum(EVEN_IN_SIZES)[:-1]]
    dq, dk, dv, cq, ckv, kpe = jnp.split(h @ w_in, cuts, axis=-1)
    q12 = dq.reshape(Bn, L, DIFF_HEADS, 2, DIFF_DH)
    k12 = dk.reshape(Bn, L, DIFF_HEADS, 2, DIFF_DH)
    v_d = dv.reshape(Bn, L, DIFF_HEADS, 2 * DIFF_DH)
    q_m = (rmsnorm(cq, q_norm_g) @ w_qb).reshape(Bn, L, MLA_HEADS, MLA_NOPE + MLA_ROPE)
    kv = (rmsnorm(ckv, kv_norm_g) @ w_kvb).reshape(Bn, L, MLA_HEADS, MLA_NOPE + MLA_V)
    rot = [q12[..., 0, :], q12[..., 1, :], k12[..., 0, :], k12[..., 1, :],
           q_m[..., MLA_NOPE:], kpe[:, :, None, :]]
    if pos is not None:
        rot = [axial_rope(t, pos[0], pos[1]) for t in rot]
    q1, q2, k1, k2, q_pe, k_pe = rot
    q_m = jnp.concatenate([q_m[..., :MLA_NOPE], q_pe], axis=-1)
    k_m = jnp.concatenate([kv[..., :MLA_NOPE], jnp.broadcast_to(k_pe, (Bn, L, MLA_HEADS, MLA_ROPE))], axis=-1)
    return q1, q2, k1, k2, v_d, q_m, k_m, kv[..., MLA_NOPE:]


def even_mixer(hl, hc, pos, w_in, lam_vec, subln_g, q_norm_g, w_qb, kv_norm_g, w_kvb, w_out,
               lam_init, need_ctx):
    lat = even_project(hl, pos, w_in, q_norm_g, w_qb, kv_norm_g, w_kvb)
    cx = even_project(hc, None, w_in, q_norm_g, w_qb, kv_norm_g, w_kvb)
    lv = lam_vec.astype(jnp.float32)
    lam = jnp.exp(jnp.sum(lv[0] * lv[1])) - jnp.exp(jnp.sum(lv[2] * lv[3])) + lam_init
    k1, k2, v_d, k_m, v_m = [jnp.concatenate([lat[i], cx[i]], axis=1) for i in (2, 3, 4, 6, 7)]

    def mix(q1, q2, q_m, k1, k2, v_d, k_m, v_m):
        return (diff_attention(q1, q2, k1, k2, v_d, lam, DIFF_SCALE),
                softmax_attention(q_m, k_m, v_m, MLA_SCALE))

    def merge(o_d, o_m):
        Bn, L = o_d.shape[:2]
        o_d = rmsnorm(o_d, subln_g) * (1.0 - lam_init)
        return jnp.concatenate([o_d.reshape(Bn, L, -1), o_m.reshape(Bn, L, -1)], axis=-1) @ w_out

    yl = merge(*sweep_query_blocks(lambda a, b, m: mix(a, b, m, k1, k2, v_d, k_m, v_m),
                                   lat[0], lat[1], lat[5]))
    yc = merge(*mix(cx[0], cx[1], cx[5], cx[2], cx[3], cx[4], cx[6], cx[7])) if need_ctx else None
    return yl, yc


def neighbourhood_attention(q, k, v, k_ctx, v_ctx, rpb):
    B, S, H, dh = q.shape
    rows = S // GRID_W
    kr = min(WIN_ROWS, rows)
    n_cb = GRID_W // Q_COLS
    kb = Q_COLS + WIN_COLS
    r = np.arange(rows)
    row_start = np.clip(r - WIN_ROWS // 2, 0, rows - kr)
    row_off = row_start[:, None] + np.arange(kr)[None, :] - r[:, None] + WIN_ROWS - 1
    cq = np.arange(GRID_W).reshape(n_cb, Q_COLS)
    cb_start = np.clip(np.arange(n_cb) * Q_COLS - WIN_COLS // 2, 0, GRID_W - kb)
    key_cols = cb_start[:, None] + np.arange(kb)[None, :]
    q_start = np.clip(cq - WIN_COLS // 2, 0, GRID_W - WIN_COLS)[:, :, None]
    kcol = key_cols[:, None, :]
    col_valid = (kcol >= q_start) & (kcol < q_start + WIN_COLS)
    col_off = np.clip(kcol - cq[:, :, None] + WIN_COLS - 1, 0, 2 * WIN_COLS - 2)
    bias = rpb.astype(jnp.float32)[:, row_off][..., col_off]
    bias = jnp.where(col_valid[None, None, None], bias, -jnp.inf)
    bias = bias.transpose(1, 0, 3, 4, 2, 5).reshape(rows, H, n_cb, Q_COLS, kr * kb)

    kg = k.reshape(B, rows, GRID_W, H, dh)
    vg = v.reshape(B, rows, GRID_W, H, dh)
    qg = jnp.moveaxis(q.reshape(B, rows, n_cb, Q_COLS, H, dh), 1, 0)
    n_loc = kr * kb

    def one_row(args):
        start, q_r, bias_r = args

        def gather(t):
            strip = lax.dynamic_slice_in_dim(t, start, kr, axis=1)
            blk = strip[:, :, key_cols]
            return blk.transpose(0, 2, 1, 3, 4, 5).reshape(B, n_cb, n_loc, H, dh)

        k_r, v_r = gather(kg), gather(vg)
        s_loc = jnp.einsum('bnqhd,bnkhd->bhnqk', q_r, k_r).astype(jnp.float32) * NA_SCALE + bias_r
        s_ctx = jnp.einsum('bnqhd,bchd->bhnqc', q_r, k_ctx).astype(jnp.float32) * NA_SCALE
        p = jax.nn.softmax(jnp.concatenate([s_loc, s_ctx], axis=-1), axis=-1).astype(v.dtype)
        return (jnp.einsum('bhnqk,bnkhd->bnqhd', p[..., :n_loc], v_r)
                + jnp.einsum('bhnqc,bchd->bnqhd', p[..., n_loc:], v_ctx))

    out = lax.map(one_row, (jnp.asarray(row_start, jnp.int32), qg, bias))
    return jnp.moveaxis(out, 0, 1).reshape(B, S, H, dh)


def odd_mixer(hl, hc, w_qkv, rpb, w_out, need_ctx):
    B, S, D = hl.shape
    C = hc.shape[1]
    q, k, v = [t.reshape(B, S, NA_HEADS, NA_DH) for t in jnp.split(hl @ w_qkv, 3, axis=-1)]
    if need_ctx:
        qc, kc, vc = [t.reshape(B, C, NA_HEADS, NA_DH) for t in jnp.split(hc @ w_qkv, 3, axis=-1)]
    else:
        kc, vc = [t.reshape(B, C, NA_HEADS, NA_DH) for t in jnp.split(hc @ w_qkv[:, D:], 2, axis=-1)]
    yl = neighbourhood_attention(q, k, v, kc, vc, rpb).reshape(B, S, D) @ w_out
    yc = softmax_attention(qc, kc, vc, NA_SCALE).reshape(B, C, D) @ w_out if need_ctx else None
    return yl, yc


def moe(h, router_w, router_b, w1, b1, w2, b2):
    T, D = h.shape
    TK = T * TOP_K
    logits = (h @ router_w + router_b).astype(jnp.float32)
    top_v, top_e = lax.top_k(logits, TOP_K)
    gate_w = jax.nn.softmax(top_v, axis=-1).reshape(TK)
    e_flat = top_e.reshape(TK)
    order = jnp.argsort(e_flat)
    e_sorted = e_flat[order]
    counts = jnp.bincount(e_flat, length=N_EXPERTS)
    padded = (counts + EXPERT_BLOCK - 1) // EXPERT_BLOCK * EXPERT_BLOCK
    start = jnp.cumsum(counts) - counts
    pad_end = jnp.cumsum(padded)
    dest = pad_end[e_sorted] - padded[e_sorted] + jnp.arange(TK) - start[e_sorted]
    n_blocks = -(-TK // EXPERT_BLOCK) + N_EXPERTS
    M = n_blocks * EXPERT_BLOCK
    row_tok = jnp.zeros((M,), jnp.int32).at[dest].set((order // TOP_K).astype(jnp.int32))
    row_w = jnp.zeros((M,), jnp.float32).at[dest].set(gate_w[order])
    blk_e = jnp.minimum(jnp.searchsorted(pad_end, jnp.arange(n_blocks) * EXPERT_BLOCK, side='right'),
                        N_EXPERTS - 1)

    def expert_block(args):
        tok, e = args
        gu = (h[tok] @ w1[e] + b1[e]).astype(jnp.float32)
        gate = jnp.minimum(gu[:, :D_FF], SWIGLU_LIMIT)
        lin = jnp.clip(gu[:, D_FF:], -SWIGLU_LIMIT, SWIGLU_LIMIT)
        act = gate * jax.nn.sigmoid(SWIGLU_ALPHA * gate) * (lin + 1.0)
        return act.astype(h.dtype) @ w2[e] + b2[e]

    out = lax.map(expert_block, (row_tok.reshape(n_blocks, EXPERT_BLOCK), blk_e))
    out = out.reshape(M, D) * row_w[:, None].astype(h.dtype)
    return jax.ops.segment_sum(out, row_tok, num_segments=T)


def setup_inputs(seed: int = 0) -> dict:
    key = jax.random.key(seed)
    ks = iter(jax.random.split(key, 32))
    D = D_MODEL
    nrm = lambda shape, s: jax.random.normal(next(ks), shape, jnp.float32) * s
    gain = lambda shape: 1.0 + nrm(shape, 0.05)
    return {
        'x': nrm((BATCH, SEQ, D), 1.0),
        'c': nrm((BATCH, D), 1.0),
        'ctx': nrm((BATCH, CTX_LEN, D), 1.0),
        'c_ctx': nrm((D,), 1.0),
        'ada_w': nrm((DEPTH, D, 6 * D), 0.5 * D ** -0.5),
        'ada_b': nrm((DEPTH, 6 * D), 0.01),
        'mix_pre_g': gain((DEPTH, D)),
        'mix_post_g': gain((DEPTH, D)),
        'ffn_pre_g': gain((DEPTH, D)),
        'ffn_post_g': gain((DEPTH, D)),
        'even_w_in': nrm((N_EVEN, D, EVEN_IN_WIDTH), D ** -0.5),
        'diff_lambda': nrm((N_EVEN, 4, DIFF_DH), 0.1),
        'diff_subln_g': gain((N_EVEN, 2 * DIFF_DH)),
        'mla_q_norm_g': gain((N_EVEN, MLA_Q_LORA)),
        'mla_w_qb': nrm((N_EVEN, MLA_Q_LORA, MLA_HEADS * (MLA_NOPE + MLA_ROPE)), MLA_Q_LORA ** -0.5),
        'mla_kv_norm_g': gain((N_EVEN, MLA_KV_LORA)),
        'mla_w_kvb': nrm((N_EVEN, MLA_KV_LORA, MLA_HEADS * (MLA_NOPE + MLA_V)), MLA_KV_LORA ** -0.5),
        'even_w_out': nrm((N_EVEN, EVEN_OUT_WIDTH, D), EVEN_OUT_WIDTH ** -0.5),
        'na_w_qkv': nrm((N_ODD, D, 3 * D), D ** -0.5),
        'na_rpb': nrm((N_ODD, NA_HEADS, 2 * WIN_ROWS - 1, 2 * WIN_COLS - 1), 0.1),
        'na_w_out': nrm((N_ODD, D, D), D ** -0.5),
        'router_w': nrm((DEPTH, D, N_EXPERTS), D ** -0.5),
        'router_b': nrm((DEPTH, N_EXPERTS), 0.01),
        'moe_w1': nrm((DEPTH, N_EXPERTS, D, 2 * D_FF), D ** -0.5),
        'moe_b1': nrm((DEPTH, N_EXPERTS, 2 * D_FF), 0.01),
        'moe_w2': nrm((DEPTH, N_EXPERTS, D_FF, D), D_FF ** -0.5),
        'moe_b2': nrm((DEPTH, N_EXPERTS, D), 0.01),
    }


def reference(x, c, ctx, c_ctx, ada_w, ada_b, mix_pre_g, mix_post_g, ffn_pre_g, ffn_post_g,
              even_w_in, diff_lambda, diff_subln_g, mla_q_norm_g, mla_w_qb, mla_kv_norm_g, mla_w_kvb,
              even_w_out, na_w_qkv, na_rpb, na_w_out, router_w, router_b, moe_w1, moe_b1, moe_w2, moe_b2):
    B, S, D = x.shape
    C = ctx.shape[1]
    t = jnp.arange(S)
    pos = (t // GRID_W, t % GRID_W)
    xl, xc = x, ctx
    for l in range(DEPTH):
        last = l == DEPTH - 1
        i = l // 2
        mod_l = jnp.split((jax.nn.silu(c) @ ada_w[l] + ada_b[l])[:, None, :], 6, axis=-1)
        mod_c = jnp.split(jax.nn.silu(c_ctx) @ ada_w[l] + ada_b[l], 6, axis=-1)
        hl = modulate(rmsnorm(xl, mix_pre_g[l]), mod_l[0], mod_l[1])
        hc = modulate(rmsnorm(xc, mix_pre_g[l]), mod_c[0], mod_c[1])
        if l % 2 == 0:
            lam_init = 0.8 - 0.6 * math.exp(-0.3 * l)
            yl, yc = even_mixer(hl, hc, pos, even_w_in[i], diff_lambda[i], diff_subln_g[i],
                                mla_q_norm_g[i], mla_w_qb[i], mla_kv_norm_g[i], mla_w_kvb[i],
                                even_w_out[i], lam_init, not last)
        else:
            yl, yc = odd_mixer(hl, hc, na_w_qkv[i], na_rpb[i], na_w_out[i], not last)
        xl = xl + mod_l[2] * rmsnorm(yl, mix_post_g[l])
        hl = modulate(rmsnorm(xl, ffn_pre_g[l]), mod_l[3], mod_l[4])
        if last:
            yl = moe(hl.reshape(B * S, D), router_w[l], router_b[l], moe_w1[l], moe_b1[l],
                     moe_w2[l], moe_b2[l]).reshape(B, S, D)
        else:
            xc = xc + mod_c[2] * rmsnorm(yc, mix_post_g[l])
            hc = modulate(rmsnorm(xc, ffn_pre_g[l]), mod_c[3], mod_c[4])
            y = moe(jnp.concatenate([hl.reshape(B * S, D), hc.reshape(B * C, D)], axis=0),
                    router_w[l], router_b[l], moe_w1[l], moe_b1[l], moe_w2[l], moe_b2[l])
            yl = y[:B * S].reshape(B, S, D)
            xc = xc + mod_c[5] * rmsnorm(y[B * S:].reshape(B, C, D), ffn_post_g[l])
        xl = xl + mod_l[5] * rmsnorm(yl, ffn_post_g[l])
    return xl
```

```cpp
#include <hip/hip_runtime.h>
#include <cstdio>
#include <cstdint>

#ifndef STOP_AFTER
#define STOP_AFTER 99
#endif

typedef unsigned short bf16_t;
typedef short bf16x8 __attribute__((ext_vector_type(8)));
typedef short s16x4 __attribute__((ext_vector_type(4)));
typedef float f32x4 __attribute__((ext_vector_type(4)));
typedef float f32x2 __attribute__((ext_vector_type(2)));
typedef float f32x16 __attribute__((ext_vector_type(16)));
typedef unsigned u32x4 __attribute__((ext_vector_type(4)));
typedef unsigned u32x2 __attribute__((ext_vector_type(2)));
#define LAS __attribute__((address_space(3)))
#define DI __device__ __forceinline__

constexpr int DM = 1024, NB = 32, SEQ = 2048, CTXL = 256, GRIDW = 64;
constexpr int TL = NB * SEQ, TC = NB * CTXL, TT = TL + TC;
constexpr int NE = 32, DFF = 1024;
constexpr int NWAVES = 8, NTHREADS = 512;
constexpr float EPS = 1e-6f;
constexpr int EVEN_IN_W = 1984, EVEN_IN_PAD = 2048;
constexpr int MAXTILES = 1184;

constexpr size_t MiB = 1u << 20;
constexpr size_t WS_CTL = 0, CTL_ZERO_BYTES = 1 * MiB;
constexpr size_t WS_MOD = 1 * MiB;
constexpr size_t WS_SCT = 3 * MiB;
constexpr size_t WS_ROPE = 3 * MiB + 256 * 1024;
constexpr size_t WS_MISC = 3 * MiB + 512 * 1024;
constexpr size_t WS_WIN = 4 * MiB, WS_WQB = 8 * MiB, WS_WKVB = 9 * MiB, WS_WOUT = 10 * MiB, WS_WQKV = 12 * MiB, WS_WNAO = 18 * MiB, WS_WR = 20 * MiB;
constexpr size_t WS_W1 = 22 * MiB, WS_W2 = 278 * MiB, WS_XC = 406 * MiB, WS_H = 438 * MiB, WS_R = 582 * MiB;
constexpr size_t R_P = 0, R_CQN = 288 * MiB, R_CKVN = 324 * MiB, R_QM = 342 * MiB, R_KVX = 450 * MiB  , R_AO = 630 * MiB, R_AOM = 774 * MiB, R_Y = 990 * MiB;
constexpr size_t R_QKV = 0, R_VT = 432 * MiB, R_NAO = 576 * MiB;
constexpr size_t R_LG = 0, R_TOPW = 9 * MiB, R_EPOS = 11 * MiB, R_SLOT = 13 * MiB, R_ROWTOK = 15 * MiB, R_ACT = 17 * MiB, R_EO = 609 * MiB;
constexpr size_t WS_H8 = WS_R + 1201 * MiB;
constexpr size_t WS_END = WS_H8 + 72 * MiB;
constexpr int CW_BAR = 4096;
constexpr int CW_CNT = 16384;
constexpr int MW_LAM = 0, MW_NT = 16  , MW_TSTART = 64  , MW_TILEE = 256  ;

constexpr int RING_BYTES = 131072, LDSCTL_OFF = RING_BYTES, MISC_OFF = LDSCTL_OFF + 320, LDS_BYTES = 147456;

DI unsigned f2bf(float f) { unsigned u = __builtin_bit_cast(unsigned, f); return (u + 0x7fffu + ((u >> 16) & 1u)) >> 16; }
DI unsigned pk2(float lo, float hi) { return f2bf(lo) | (f2bf(hi) << 16); }
DI float bflo(unsigned w) { return __builtin_bit_cast(float, w << 16); }
DI float bfhi(unsigned w) { return __builtin_bit_cast(float, w & 0xffff0000u); }
DI unsigned cvt_pk_bf16(float lo, float hi) { unsigned r; asm volatile("v_cvt_pk_bf16_f32 %0, %1, %2" : "=v"(r) : "v"(lo), "v"(hi)); return r; }
DI unsigned pk4_fp8(float a, float b, float c, float d) { unsigned w = 0; w = __builtin_amdgcn_cvt_pk_fp8_f32(a, b, w, false); w = __builtin_amdgcn_cvt_pk_fp8_f32(c, d, w, true); return w; }
template <int CTRL> DI float dppf(float v) { return __builtin_bit_cast(float, __builtin_amdgcn_update_dpp(0, __builtin_bit_cast(int, v), CTRL, 0xf, 0xf, true)); }
DI float row16_sum(float v) { v += dppf<0xB1>(v); v += dppf<0x4E>(v); v += dppf<0x141>(v); v += dppf<0x140>(v); return v; }
DI float half_sum(float v) { v = row16_sum(v); auto r = __builtin_amdgcn_permlane16_swap(__builtin_bit_cast(unsigned, v), __builtin_bit_cast(unsigned, v), false, false); return __uint_as_float(r[0]) + __uint_as_float(r[1]); }
DI float wave_sum(float v) { v = half_sum(v); auto r = __builtin_amdgcn_permlane32_swap(__builtin_bit_cast(unsigned, v), __builtin_bit_cast(unsigned, v), false, false); return __uint_as_float(r[0]) + __uint_as_float(r[1]); }
DI float half_max(float v) {
    v = fmaxf(v, dppf<0xB1>(v)); v = fmaxf(v, dppf<0x4E>(v)); v = fmaxf(v, dppf<0x141>(v)); v = fmaxf(v, dppf<0x140>(v));
    auto r = __builtin_amdgcn_permlane16_swap(__builtin_bit_cast(unsigned, v), __builtin_bit_cast(unsigned, v), false, false); return fmaxf(__uint_as_float(r[0]), __uint_as_float(r[1]));
}
#define LDS_WAIT() asm volatile("s_waitcnt lgkmcnt(0)" ::: "memory")
#define VM_WAIT() asm volatile("s_waitcnt vmcnt(0)" ::: "memory")

#define XB_TMO      128
#define XB_XCNT(j)  (256  + 64 * (j))
#define XB_XSUB(j)  (1280 + 64 * (j))
#define XB_XGEN(j)  (2304 + 64 * (j))
#define XB_TOP      3328
#define XB_TOPGEN   3392
#define XCD_BAR_WORDS 3456
#define XB_SPIN_CAP (1u << 20)

__device__ __forceinline__ unsigned xb_ld(unsigned* p)              { return __hip_atomic_load(p, __ATOMIC_RELAXED, __HIP_MEMORY_SCOPE_AGENT); }
__device__ __forceinline__ unsigned xb_add(unsigned* p, unsigned v) { return __hip_atomic_fetch_add(p, v, __ATOMIC_RELAXED, __HIP_MEMORY_SCOPE_AGENT); }
__device__ __forceinline__ unsigned xb_xcc_id() { return (unsigned)__builtin_amdgcn_s_getreg((3 << 11) | 20) & 0xFu; }
#define XB_SPIN(cond, bar) do { unsigned _sp = 0; while (cond) { __builtin_amdgcn_s_sleep(1); \
    if ((++_sp & 255u) == 0u) { if (xb_ld(&(bar)[XB_TMO])) break; if (_sp > XB_SPIN_CAP) { atomicAdd(&(bar)[XB_TMO], 1u); break; } } } } while (0)

struct XcdBarrier { unsigned* bar; unsigned x; volatile LAS unsigned* st; };

__device__ __forceinline__ XcdBarrier xcd_barrier_post(unsigned* bar, volatile LAS unsigned* st) {
    XcdBarrier b; b.bar = bar; b.x = xb_xcc_id(); b.st = st;
    if (threadIdx.x == 0) (void)xb_add(&bar[XB_XCNT(b.x)], 1u);
    return b;
}
__device__ __forceinline__ void xcd_barrier_complete(unsigned* bar, unsigned x, unsigned& nloc, unsigned& nx) {
    const unsigned G = gridDim.x * gridDim.y * gridDim.z;
    unsigned sum, cnt, mine, sp = 0u;
    for (;;) {
        sum = 0u; cnt = 0u; mine = 0u;
#pragma unroll 1
        for (unsigned j = 0; j < 16; ++j) { const unsigned c = xb_ld(&bar[XB_XCNT(j)]); sum += c; cnt += (c > 0u) ? 1u : 0u; mine = (j == x) ? c : mine; }
        if (sum == G) break;
        __builtin_amdgcn_s_sleep(1);
        if ((++sp & 255u) == 0u) { if (xb_ld(&bar[XB_TMO])) break; if (sp > XB_SPIN_CAP) { atomicAdd(&bar[XB_TMO], 1u); break; } }
    }
    nloc = mine > 0u ? mine : 1u; nx = cnt > 0u ? cnt : 1u;
}
__device__ __forceinline__ void xcd_barrier(const XcdBarrier& b) {
    asm volatile("s_waitcnt vmcnt(0)" ::: "memory");
    __syncthreads();
    if (threadIdx.x == 0) {
        unsigned* bar = b.bar;
        __builtin_amdgcn_s_waitcnt(0);
        unsigned nloc = b.st[0], nx = b.st[1];
        if (nloc == 0u) { xcd_barrier_complete(bar, b.x, nloc, nx); b.st[0] = nloc; b.st[1] = nx; }
        const unsigned old = xb_add(&bar[XB_XSUB(b.x)], 1u);
        const unsigned gen = old / nloc;
        if (old + 1u == (gen + 1u) * nloc) {
            __builtin_amdgcn_fence(__ATOMIC_RELEASE, "agent");
            asm volatile("s_waitcnt vmcnt(0)" ::: "memory");
            const unsigned og = xb_add(&bar[XB_TOP], 1u);
            const unsigned tg = og / nx;
            if (og + 1u == (tg + 1u) * nx) xb_add(&bar[XB_TOPGEN], 1u);
            else XB_SPIN(xb_ld(&bar[XB_TOPGEN]) == tg, bar);
            __builtin_amdgcn_fence(__ATOMIC_ACQUIRE, "agent");
            xb_add(&bar[XB_XGEN(b.x)], 1u);
            asm volatile("s_waitcnt vmcnt(0)" ::: "memory");
        } else {
            XB_SPIN(xb_ld(&bar[XB_XGEN(b.x)]) == gen, bar);
            __builtin_amdgcn_fence(__ATOMIC_ACQUIRE, "agent");
            asm volatile("s_waitcnt vmcnt(0)" ::: "memory");
        }
    }
    __syncthreads();
}
namespace pg8 {
constexpr int BM = 256, BK = 64, HALF = 128, HTB = HALF * BK * 2, STAGE_BYTES = 8 * HTB, NXCD = 8, WGM = 8;
DI int lds_byte(int r, int c) { const int st = (r >> 4) * 2 + (c >> 5), rr = r & 15, cc = c & 31, ob = rr * 64 + cc * 2; return st * 1024 + (ob ^ (((ob >> 9) & 1) << 5)); }
DI void stage_rc(int b, int& R, int& C) { const int st = b / 1024, sb = b % 1024, swz = sb ^ (((sb >> 9) & 1) << 5); R = (st >> 1) * 16 + swz / 64; C = (st & 1) * 32 + (swz % 64) / 2; }
DI int perm32(int rho) { const int n = rho >> 4, i = rho & 15; return 8 * (i >> 2) + 4 * n + (i & 3); }

struct Unit { int pm, pn, e; };
DI bool static_unit(int i, int G, int c, int nM, int nN, Unit& u) {
    const int nwg = nM * nN; const long L = (long)i * G + c; if (L >= nwg) return false;
    int wgid = (int)L; { const int q = nwg / NXCD, r = nwg % NXCD, xcd = wgid % NXCD, off = wgid / NXCD; wgid = (xcd < r ? xcd * (q + 1) : r * (q + 1) + (xcd - r) * q) + off; }
    const int nig = WGM * nN, gid = wgid / nig, fm = gid * WGM, gsz = (nM - fm) < WGM ? (nM - fm) : WGM;
    u.pm = fm + ((wgid % nig) % gsz); u.pn = (wgid % nig) / gsz; u.e = 0; return true;
}

typedef int v8i __attribute__((ext_vector_type(8)));
typedef int v4i __attribute__((ext_vector_type(4)));
template <class Prob, class Epi, bool F8 = false>
DI void gemm_phase(LAS unsigned char* lds, const Prob& P, const Epi& E, int tid, int probe = 0) {
    const int wid = __builtin_amdgcn_readfirstlane(tid >> 6), lane = tid & 63, wr = wid >> 2, wc = wid & 3, fr = lane & 15, fq = lane >> 4;
    int Kv = P.KB; asm volatile("" : "+s"(Kv));
    const int KB = Kv, nt = (probe & 2) ? KB / 256 : KB / 128;
    unsigned voffB0[2], voffB1[2];
#pragma unroll
    for (int i = 0; i < 2; ++i) { int R, C; stage_rc(tid * 16 + i * 8192, R, C);
        if constexpr (Epi::WIDE) { const int wcc = R >> 5, rho = R & 31, nn = rho >> 4, ii = rho & 15, colb = wcc * 64 + (ii >> 2) * 16 + nn * 4 + (ii & 3);
            voffB0[i] = (unsigned)(colb * KB + C * 2); voffB1[i] = (unsigned)((colb + 8) * KB + C * 2); }
        else { const int Rb = Epi::PERM ? ((R & ~31) + perm32(R & 31)) : R; voffB0[i] = (unsigned)(Rb * KB + C * 2); voffB1[i] = voffB0[i]; } }
    const size_t kstep = (size_t)(BK * 2);
    const unsigned ldsw = (unsigned)wid * 1024u;
    const int aoff = lds_byte(wr * 64 + fr, fq * 8), boff = lds_byte(wc * 32 + fr, fq * 8);
#define PG8_SA(b, h) (((b) * 2 + (h)) * HTB)
#define PG8_SB(b, h) ((4 + (b) * 2 + (h)) * HTB)
#define PG8_STAGE_B(bufoff, gptr, voffB) do { const char* _g = (const char*)(gptr); asm volatile("" : "+s"(_g)); _Pragma("unroll") for (int _i = 0; _i < 2; ++_i) \
        { unsigned _o = voffB[_i]; asm volatile("" : "+v"(_o)); __builtin_amdgcn_global_load_lds((const unsigned*)(_g + _o), (LAS unsigned*)(lds + (bufoff) + ldsw + _i * 8192), 16, 0, 0); } } while (0)
#define PG8_STAGE_A(bufoff, gptr, offs) do { const char* _g = (const char*)(gptr); asm volatile("" : "+s"(_g)); _Pragma("unroll") for (int _i = 0; _i < 2; ++_i) \
        { unsigned _o = (offs)[_i]; asm volatile("" : "+v"(_o)); __builtin_amdgcn_global_load_lds((const unsigned*)(_g + _o), (LAS unsigned*)(lds + (bufoff) + ldsw + _i * 8192), 16, 0, 0); } } while (0)
#define PG8_LDA(dst, b, h) do { _Pragma("unroll") for (int m = 0; m < 4; ++m) _Pragma("unroll") for (int k = 0; k < 2; ++k) dst[m][k] = *(const LAS bf16x8*)(lds + PG8_SA(b, h) + aoff + m * 2048 + k * 1024); } while (0)
#define PG8_LDB(dst, b, h) do { _Pragma("unroll") for (int n = 0; n < 2; ++n) _Pragma("unroll") for (int k = 0; k < 2; ++k) dst[n][k] = *(const LAS bf16x8*)(lds + PG8_SB(b, h) + boff + n * 2048 + k * 1024); } while (0)
#define PG8_CAT(x) __builtin_bit_cast(v8i, __builtin_shufflevector(__builtin_bit_cast(v4i, (x)[0]), __builtin_bit_cast(v4i, (x)[1]), 0, 1, 2, 3, 4, 5, 6, 7))
#define PG8_MMA(ai, bj, At, Bt) do { __builtin_amdgcn_s_setprio(1); _Pragma("unroll") for (int m = 0; m < 4; ++m) _Pragma("unroll") for (int n = 0; n < 2; ++n) { \
        if constexpr (F8) acc[ai][bj][m][n] = __builtin_amdgcn_mfma_scale_f32_16x16x128_f8f6f4(PG8_CAT(Bt[n]), PG8_CAT(At[m]), acc[ai][bj][m][n], 0, 0, 0, 0x7a7a7a7a, 0, 0x7f7f7f7f); \
        else { _Pragma("unroll") for (int k = 0; k < 2; ++k) acc[ai][bj][m][n] = __builtin_amdgcn_mfma_f32_16x16x32_bf16(Bt[n][k], At[m][k], acc[ai][bj][m][n], 0, 0, 0); } } \
        __builtin_amdgcn_s_setprio(0); } while (0)
#define PG8_WAIT_V(n) asm volatile("s_waitcnt vmcnt(" #n ")" ::: "memory")
#define PG8_WAIT_L(n) asm volatile("s_waitcnt lgkmcnt(" #n ")" ::: "memory")
#define PG8_BAR __builtin_amdgcn_s_barrier()
#define PG8_SCHED __builtin_amdgcn_sched_barrier(0)
    LAS unsigned char* const hdr = lds + STAGE_BYTES + 1024;
#define PG8_HROW(u_) ((LAS unsigned*)(hdr + ((u_) % 3) * 2048))
#define PG8_HBIAS(u_) ((LAS float*)(hdr + ((u_) % 3) * 2048 + 1024))
#define PG8_LOAD_HDR(un, u_) do { \
        if constexpr (Prob::GATHER) { if (wid < 4) __builtin_amdgcn_global_load_lds((const unsigned*)(P.rowtok + (un).pm * BM + wid * 64 + lane), (LAS unsigned*)(PG8_HROW(u_) + wid * 64), 4, 0, 0); } \
        if constexpr (Epi::BIAS) { if (wid >= 4) __builtin_amdgcn_global_load_lds((const unsigned*)(E.bias_src(un, (wid - 4) * 64) + lane), (LAS unsigned*)(PG8_HBIAS(u_) + (wid - 4) * 64), 4, 0, 0); } } while (0)
    Unit cur, nxt; int ui = 0;
    if (!P.next(0, cur)) return;
    if constexpr (Prob::GATHER || Epi::BIAS) { PG8_LOAD_HDR(cur, 0); asm volatile("s_waitcnt vmcnt(0)" ::: "memory"); __builtin_amdgcn_s_barrier(); asm volatile("" ::: "memory"); }
    f32x4 acc[2][2][4][2];
#pragma unroll
    for (int a = 0; a < 2; ++a)
#pragma unroll
        for (int b = 0; b < 2; ++b)
#pragma unroll
            for (int m = 0; m < 4; ++m)
#pragma unroll
                for (int n = 0; n < 2; ++n) acc[a][b][m][n] = (f32x4){0.f, 0.f, 0.f, 0.f};
    bf16x8 At[4][2], B0[2][2], B1[2][2];
    unsigned oa0[2], oa1[2];
#pragma unroll
    for (int i = 0; i < 2; ++i) { int R, C; stage_rc(tid * 16 + i * 8192, R, C); oa0[i] = P.a_lane(cur, 0, R, C, PG8_HROW(0)); oa1[i] = P.a_lane(cur, 1, R, C, PG8_HROW(0)); }
    const char* cA0 = P.a_base(cur, 0); const char* cA1 = P.a_base(cur, 1);
    const char* cB0 = P.b_base(cur, 0); const char* cB1 = P.b_base(cur, Epi::WIDE ? 0 : 1);
    PG8_STAGE_B(PG8_SB(0, 0), cB0, voffB0); PG8_STAGE_B(PG8_SB(0, 1), cB1, voffB1); PG8_STAGE_A(PG8_SA(0, 0), cA0, oa0); PG8_STAGE_A(PG8_SA(0, 1), cA1, oa1);
    if (wr == 1) PG8_BAR;
    PG8_WAIT_V(2); PG8_BAR;
    PG8_STAGE_B(PG8_SB(1, 0), cB0 + kstep, voffB0); PG8_STAGE_A(PG8_SA(1, 0), cA0 + kstep, oa0); PG8_STAGE_B(PG8_SB(1, 1), cB1 + kstep, voffB1);
    PG8_WAIT_V(6); PG8_BAR;
    for (;;) {
        const bool has_next = P.next(ui + 1, nxt);
        if constexpr (Prob::GATHER || Epi::BIAS) { if (has_next) PG8_LOAD_HDR(nxt, ui + 1); }
        for (int t = 0; t < nt; t += 2) {
            const bool last = (t == nt - 2);
            PG8_LDB(B0, 0, 0); PG8_LDB(B1, 0, 1); PG8_SCHED; PG8_LDA(At, 0, 0); PG8_STAGE_A(PG8_SA(1, 1), cA1 + (size_t)(t + 1) * kstep, oa1);
            PG8_WAIT_V(8); PG8_WAIT_L(0); PG8_BAR; PG8_MMA(0, 0, At, B0); PG8_MMA(0, 1, At, B1); PG8_BAR; PG8_SCHED;
            size_t k2 = (size_t)(t + 2) * kstep;
            if (last) { k2 = 0; if (has_next) { cB0 = P.b_base(nxt, 0); cB1 = P.b_base(nxt, Epi::WIDE ? 0 : 1); cA0 = P.a_base(nxt, 0); cA1 = P.a_base(nxt, 1);
#pragma unroll
                for (int i = 0; i < 2; ++i) { int R, C; stage_rc(tid * 16 + i * 8192, R, C); oa0[i] = P.a_lane(nxt, 0, R, C, PG8_HROW(ui + 1)); oa1[i] = P.a_lane(nxt, 1, R, C, PG8_HROW(ui + 1)); } } }
            const size_t k3 = k2 + kstep;
            PG8_LDA(At, 0, 1); PG8_STAGE_B(PG8_SB(0, 0), cB0 + k2, voffB0); PG8_STAGE_B(PG8_SB(0, 1), cB1 + k2, voffB1); PG8_STAGE_A(PG8_SA(0, 0), cA0 + k2, oa0);
            PG8_WAIT_V(8); PG8_WAIT_L(0); PG8_BAR; PG8_MMA(1, 0, At, B0); PG8_MMA(1, 1, At, B1); PG8_BAR; PG8_SCHED;
            PG8_LDB(B0, 1, 0); PG8_LDB(B1, 1, 1); PG8_SCHED; PG8_LDA(At, 1, 0); PG8_STAGE_A(PG8_SA(0, 1), cA1 + k2, oa1);
            PG8_WAIT_V(8); PG8_WAIT_L(0); PG8_BAR; PG8_MMA(0, 0, At, B0); PG8_MMA(0, 1, At, B1); PG8_BAR; PG8_SCHED;
            PG8_LDA(At, 1, 1); PG8_STAGE_B(PG8_SB(1, 0), cB0 + k3, voffB0); PG8_STAGE_B(PG8_SB(1, 1), cB1 + k3, voffB1); PG8_STAGE_A(PG8_SA(1, 0), cA0 + k3, oa0);
            PG8_WAIT_V(8); PG8_WAIT_L(0); PG8_BAR; PG8_MMA(1, 0, At, B0); PG8_MMA(1, 1, At, B1); PG8_BAR; PG8_SCHED;
        }
        if (wr == 0) PG8_BAR;
        if (!(probe & 1)) E(acc, cur, wr, wc, fr, fq, PG8_HBIAS(ui));
        if (!has_next) break;
#pragma unroll
        for (int a = 0; a < 2; ++a)
#pragma unroll
            for (int b = 0; b < 2; ++b)
#pragma unroll
                for (int m = 0; m < 4; ++m)
#pragma unroll
                    for (int n = 0; n < 2; ++n) acc[a][b][m][n] = (f32x4){0.f, 0.f, 0.f, 0.f};
        cur = nxt; ++ui;
        if (wr == 1) PG8_BAR;
    }
    PG8_WAIT_V(0);
    PG8_BAR;
#undef PG8_HROW
#undef PG8_HBIAS
#undef PG8_LOAD_HDR
#undef PG8_SA
#undef PG8_SB
#undef PG8_STAGE_A
#undef PG8_STAGE_B
#undef PG8_LDA
#undef PG8_LDB
#undef PG8_MMA
#undef PG8_CAT
#undef PG8_WAIT_V
#undef PG8_WAIT_L
#undef PG8_BAR
#undef PG8_SCHED
}

struct DenseProb {
    static constexpr bool GATHER = false;
    const bf16_t* A; const bf16_t* Bt; int KB  , nM, nN, G, c;
    DI bool next(int i, Unit& u) const { return static_unit(i, G, c, nM, nN, u); }
    DI unsigned a_lane(const Unit&, int, int R, int C, const LAS unsigned*) const { return (unsigned)(R * KB + C * 2); }
    DI const char* a_base(const Unit& u, int h) const { return (const char*)A + (size_t)(u.pm * BM + h * HALF) * KB; }
    DI const char* b_base(const Unit& u, int h) const { return (const char*)Bt + (size_t)(u.pn * BM + h * HALF) * KB; }
};
struct DenseProb8 {
    static constexpr bool GATHER = false;
    const unsigned char* A; const unsigned char* Bt; int KB, nM, nN, G, c;
    DI bool next(int i, Unit& u) const { return static_unit(i, G, c, nM, nN, u); }
    DI unsigned a_lane(const Unit&, int, int R, int C, const LAS unsigned*) const { return (unsigned)(R * KB + C * 2); }
    DI const char* a_base(const Unit& u, int h) const { return (const char*)A + (size_t)(u.pm * BM + h * HALF) * KB; }
    DI const char* b_base(const Unit& u, int h) const { return (const char*)Bt + (size_t)(u.pn * BM + h * HALF) * KB; }
};
struct Moe1Prob {
    static constexpr bool GATHER = true;
    const unsigned char* A; const unsigned char* W1t; const unsigned* rowtok; const int* tile_e; int KB, nM, G, c;
    DI bool next(int i, Unit& u) const { if (!static_unit(i, G, c, nM, 8, u)) return false; u.e = __builtin_amdgcn_readfirstlane(tile_e[u.pm]); return true; }
    DI unsigned a_lane(const Unit&, int h, int R, int C, const LAS unsigned* hrow) const { return hrow[h * HALF + R] * (unsigned)KB + (unsigned)(C * 2); }
    DI const char* a_base(const Unit&, int) const { return (const char*)A; }
    DI const char* b_base(const Unit& u, int h) const { return (const char*)W1t + ((size_t)u.e * 2048 + (size_t)h * 1024 + (size_t)u.pn * 128) * KB; }
};
struct Moe2Prob {
    static constexpr bool GATHER = false;
    const unsigned char* A; const unsigned char* W2t; const int* tile_e; int KB, nM, G, c;
    DI bool next(int i, Unit& u) const { if (!static_unit(i, G, c, nM, 4, u)) return false; u.e = __builtin_amdgcn_readfirstlane(tile_e[u.pm]); return true; }
    DI unsigned a_lane(const Unit&, int, int R, int C, const LAS unsigned*) const { return (unsigned)(R * KB + C * 2); }
    DI const char* a_base(const Unit& u, int h) const { return (const char*)A + (size_t)(u.pm * BM + h * HALF) * KB; }
    DI const char* b_base(const Unit& u, int h) const { return (const char*)W2t + ((size_t)u.e * 1024 + (size_t)u.pn * BM + (size_t)h * HALF) * KB; }
};

template <bool W> struct EpiBf16T {
    static constexpr bool PERM = true, BIAS = false, WIDE = W;
    bf16_t* O; int ldc; int tcol, hcol;
    DI const float* bias_src(const Unit&, int) const { return nullptr; }
    DI void operator()(const f32x4 (&acc)[2][2][4][2], const Unit& u, int wr, int wc, int fr, int fq, const LAS float*) const {
        const int row0 = u.pm * BM + wr * 64 + fr, ocol0 = W ? u.pn * BM + wc * 64 + 16 * fq : u.pn * tcol + wc * 32 + 8 * fq;
#pragma unroll
        for (int ai = 0; ai < 2; ++ai)
#pragma unroll
            for (int m = 0; m < 4; ++m) { bf16_t* rowp = O + (size_t)(row0 + ai * HALF + m * 16) * ldc + ocol0;
#pragma unroll
                for (int bj = 0; bj < 2; ++bj) { const f32x4 v0 = acc[ai][bj][m][0], v1 = acc[ai][bj][m][1];
                    u32x4 w; w.x = cvt_pk_bf16(v0[0], v0[1]); w.y = cvt_pk_bf16(v0[2], v0[3]); w.z = cvt_pk_bf16(v1[0], v1[1]); w.w = cvt_pk_bf16(v1[2], v1[3]);
                    *(u32x4*)(rowp + bj * (W ? 8 : hcol)) = w; } }
    }
};
typedef EpiBf16T<true> EpiBf16W; typedef EpiBf16T<false> EpiBf16;
struct EpiInproj {
    static constexpr bool PERM = true, BIAS = false, WIDE = true;
    bf16_t* O; int ldc; const LAS float* ropel;
    DI const float* bias_src(const Unit&, int) const { return nullptr; }
    DI void operator()(const f32x4 (&acc)[2][2][4][2], const Unit& u, int wr, int wc, int fr, int fq, const LAS float*) const {
        const int row0 = u.pm * BM + wr * 64 + fr, ocol0 = u.pn * BM + wc * 64 + 16 * fq;
        const bool rot = (u.pn < 4) && (u.pm < TL / BM);
        const float sgn = (fq & 1) ? 1.0f : -1.0f;
#pragma unroll
        for (int ai = 0; ai < 2; ++ai)
#pragma unroll
            for (int m = 0; m < 4; ++m) { const int row = row0 + ai * HALF + m * 16; bf16_t* rowp = O + (size_t)row * ldc + ocol0;
                float v[16];
#pragma unroll
                for (int bj = 0; bj < 2; ++bj)
#pragma unroll
                    for (int n = 0; n < 2; ++n)
#pragma unroll
                        for (int j = 0; j < 4; ++j) v[8 * bj + 4 * n + j] = acc[ai][bj][m][n][j];
                if (rot) { const int sq = row & (SEQ - 1), pos = (fq < 2) ? (sq >> 6) : (sq & (GRIDW - 1));
                    const LAS f32x4* cs = (const LAS f32x4*)(ropel + pos * 32);
#pragma unroll
                    for (int q = 0; q < 8; ++q) { const f32x4 c2 = cs[q];
                        const float p0 = __shfl_xor(v[2 * q], 16), p1 = __shfl_xor(v[2 * q + 1], 16);
                        v[2 * q] = v[2 * q] * c2[0] + sgn * p0 * c2[1]; v[2 * q + 1] = v[2 * q + 1] * c2[2] + sgn * p1 * c2[3]; } }
                u32x4 w0, w1;
                w0.x = cvt_pk_bf16(v[0], v[1]); w0.y = cvt_pk_bf16(v[2], v[3]); w0.z = cvt_pk_bf16(v[4], v[5]); w0.w = cvt_pk_bf16(v[6], v[7]);
                w1.x = cvt_pk_bf16(v[8], v[9]); w1.y = cvt_pk_bf16(v[10], v[11]); w1.z = cvt_pk_bf16(v[12], v[13]); w1.w = cvt_pk_bf16(v[14], v[15]);
                *(u32x4*)rowp = w0; *(u32x4*)(rowp + 8) = w1; }
    }
};
struct EpiF8 {
    static constexpr bool PERM = true, BIAS = true, WIDE = true;
    unsigned char* O; int ldc; const float* bias; int bias_estride;
    DI const float* bias_src(const Unit& u, int idx0) const { return bias + (size_t)u.e * bias_estride + u.pn * BM + idx0; }
    DI void operator()(const f32x4 (&acc)[2][2][4][2], const Unit& u, int wr, int wc, int fr, int fq, const LAS float* hb) const {
        const int row0 = u.pm * BM + wr * 64 + fr, x0 = wc * 64 + 16 * fq, col0 = u.pn * BM + x0;
        f32x4 bv[2][2];
#pragma unroll
        for (int bj = 0; bj < 2; ++bj)
#pragma unroll
            for (int n = 0; n < 2; ++n) bv[bj][n] = *(const LAS f32x4*)(hb + x0 + 8 * bj + 4 * n);
#pragma unroll
        for (int ai = 0; ai < 2; ++ai)
#pragma unroll
            for (int m = 0; m < 4; ++m) { unsigned char* rowp = O + (size_t)(row0 + ai * HALF + m * 16) * ldc + col0;
                u32x4 w;
                { const f32x4 v0 = acc[ai][0][m][0] + bv[0][0], v1 = acc[ai][0][m][1] + bv[0][1]; w.x = pk4_fp8(v0[0], v0[1], v0[2], v0[3]); w.y = pk4_fp8(v1[0], v1[1], v1[2], v1[3]); }
                { const f32x4 v0 = acc[ai][1][m][0] + bv[1][0], v1 = acc[ai][1][m][1] + bv[1][1]; w.z = pk4_fp8(v0[0], v0[1], v0[2], v0[3]); w.w = pk4_fp8(v1[0], v1[1], v1[2], v1[3]); }
                *(u32x4*)rowp = w; }
    }
};
struct EpiSwiglu {
    static constexpr bool PERM = true, BIAS = true, WIDE = false;
    unsigned char* O; const float* b1;
    DI const float* bias_src(const Unit& u, int idx0) const { return b1 + (size_t)u.e * 2048 + (idx0 < 128 ? u.pn * 128 + idx0 : 1024 + u.pn * 128 + (idx0 - 128)); }
    DI void operator()(const f32x4 (&acc)[2][2][4][2], const Unit& u, int wr, int wc, int fr, int fq, const LAS float* hb) const {
        const int row0 = u.pm * BM + wr * 64 + fr, x0 = wc * 32 + 8 * fq, col0 = u.pn * 128 + x0;
        f32x4 bg[2], bl[2];
#pragma unroll
        for (int n = 0; n < 2; ++n) { bg[n] = *(const LAS f32x4*)(hb + x0 + 4 * n); bl[n] = *(const LAS f32x4*)(hb + 128 + x0 + 4 * n) + 1.0f; }
        constexpr float KE = -1.702f * 1.4426950408889634f;
#pragma unroll
        for (int ai = 0; ai < 2; ++ai)
#pragma unroll
            for (int m = 0; m < 4; ++m) { unsigned char* rowp = O + (size_t)(row0 + ai * HALF + m * 16) * DFF + col0;
                float r[8];
#pragma unroll
                for (int n = 0; n < 2; ++n) { const f32x4 g4 = acc[ai][0][m][n] + bg[n], l4 = acc[ai][1][m][n] + bl[n];
#pragma unroll
                    for (int jp = 0; jp < 2; ++jp) {
                        f32x2 g = {fminf(g4[2 * jp], 7.0f), fminf(g4[2 * jp + 1], 7.0f)};
                        const f32x2 l1 = {__builtin_amdgcn_fmed3f(l4[2 * jp], -6.0f, 8.0f), __builtin_amdgcn_fmed3f(l4[2 * jp + 1], -6.0f, 8.0f)};
                        const f32x2 t = g * KE;
                        f32x2 e = {__builtin_amdgcn_exp2f(t.x), __builtin_amdgcn_exp2f(t.y)};
                        e = e + 1.0f;
                        const f32x2 s = {__builtin_amdgcn_rcpf(e.x), __builtin_amdgcn_rcpf(e.y)};
                        const f32x2 o2 = (g * s) * l1;
                        r[4 * n + 2 * jp] = o2.x; r[4 * n + 2 * jp + 1] = o2.y; } }
                u32x2 w; w.x = pk4_fp8(r[0], r[1], r[2], r[3]); w.y = pk4_fp8(r[4], r[5], r[6], r[7]);
                *(u32x2*)rowp = w; }
    }
};
struct EpiLogits {
    static constexpr bool PERM = false, BIAS = false, WIDE = false;
    float* LG; const float* rb;
    DI const float* bias_src(const Unit&, int) const { return nullptr; }
    DI void operator()(const f32x4 (&acc)[2][2][4][2], const Unit& u, int wr, int wc, int fr, int fq, const LAS float*) const {
        if (wc != 0) return;
        const int row0 = u.pm * BM + wr * 64 + fr;
#pragma unroll
        for (int n = 0; n < 2; ++n) { const f32x4 bv = *(const f32x4*)(rb + 16 * n + 4 * fq);
#pragma unroll
            for (int ai = 0; ai < 2; ++ai)
#pragma unroll
                for (int m = 0; m < 4; ++m) *(f32x4*)(LG + (size_t)(row0 + ai * HALF + m * 16) * 32 + 16 * n + 4 * fq) = acc[ai][0][m][n] + bv; }
    }
};
}
struct Params { const float* in[27]; float* out; unsigned char* ws; };
enum { I_X = 0, I_C, I_CTX, I_CCTX, I_ADAW, I_ADAB, I_MIXPRE, I_MIXPOST, I_FFNPRE, I_FFNPOST, I_EWIN, I_DLAM, I_SUBLN, I_QNG, I_WQB, I_KVNG, I_WKVB, I_EWOUT,
       I_NAQKV, I_NARPB, I_NAWOUT, I_RW, I_RB, I_W1, I_B1, I_W2, I_B2 };

template <class T> DI T* rfl_ptr(T* p) { const unsigned long long v = (unsigned long long)p; const unsigned lo = __builtin_amdgcn_readfirstlane((unsigned)v), hi = __builtin_amdgcn_readfirstlane((unsigned)(v >> 32)); return (T*)(((unsigned long long)hi << 32) | lo); }
template <class T> DI T* launder(T* p) { const unsigned long long v = (unsigned long long)p; unsigned lo = (unsigned)v, hi = (unsigned)(v >> 32); asm volatile("" : "+v"(lo), "+v"(hi)); lo = __builtin_amdgcn_readfirstlane(lo); hi = __builtin_amdgcn_readfirstlane(hi);
    typedef __attribute__((address_space(1))) T GT; GT* g = (GT*)(((unsigned long long)hi << 32) | lo); return (T*)g; }
struct Ctx {
    const Params* prm; float* out; unsigned char* ws; LAS unsigned char* lds;
    DI const float* in(int i) const { return prm->in[i]; }
    int tid, lane, wave, G, blk, gw, NGW, vcu;

    DI float* xc() const { return (float*)(ws + WS_XC); }
    DI float* mod(int l, int bidx) const { return (float*)(ws + WS_MOD) + ((size_t)l * 33 + bidx) * 6144; }
    DI bf16_t* H() const { return (bf16_t*)(ws + WS_H); }
    DI unsigned* misc() const { return (unsigned*)(ws + WS_MISC); }
    DI unsigned* ctl() const { return (unsigned*)(ws + WS_CTL); }
    template <class T> DI T* r(size_t off) const { return (T*)(ws + WS_R + off); }
};

DI Ctx mk_ctx(const Params& prm, LAS unsigned char* lds) {
    Ctx c;
    c.prm = &prm; c.out = launder(prm.out); c.ws = launder(prm.ws); c.lds = lds;
    int t = threadIdx.x; asm volatile("" : "+v"(t));
    c.tid = t; c.lane = t & 63; c.wave = __builtin_amdgcn_readfirstlane(t >> 6);
    c.G = gridDim.x; c.blk = blockIdx.x; c.gw = c.blk * NWAVES + c.wave; c.NGW = c.G * NWAVES;
    c.vcu = (c.G % 8 == 0) ? (c.blk % 8) * (c.G / 8) + c.blk / 8 : c.blk;
    return c;
}
DI float* xrow(const Ctx& c, int m) { return m < TL ? c.out + (size_t)m * DM : c.xc() + (size_t)(m - TL) * DM; }
DI const float* xin_row(const Ctx& c, int m) { return m < TL ? c.in(I_X) + (size_t)m * DM : c.in(I_CTX) + (size_t)(m - TL) * DM; }
DI int mod_idx(int m) { return m < TL ? (m >> 11) : 32; }

DI void transpose_item(const float* W, int K, int N, bf16_t* WT, int row_off, LAS float* scr, int item, int lane) {
    const int nblk = N / 32, kb = item / nblk, nb = item % nblk, k0 = 64 * kb, n0 = 32 * nb;
    float wv[32];
#pragma unroll
    for (int i = 0; i < 32; ++i) wv[i] = W[(size_t)(k0 + 2 * i + (lane >> 5)) * N + n0 + (lane & 31)];
#pragma unroll
    for (int i = 0; i < 32; ++i) scr[(2 * i + (lane >> 5)) * 33 + (lane & 31)] = wv[i];
    LDS_WAIT(); asm volatile("" ::: "memory");
    const int cch = lane & 7;
#pragma unroll
    for (int j = 0; j < 4; ++j) { const int n = (lane >> 3) + 8 * j; const LAS float* s = scr + (8 * cch) * 33 + n;
        u32x4 o; o.x = pk2(s[0 * 33], s[1 * 33]); o.y = pk2(s[2 * 33], s[3 * 33]); o.z = pk2(s[4 * 33], s[5 * 33]); o.w = pk2(s[6 * 33], s[7 * 33]);
        *(u32x4*)(WT + (size_t)(row_off + n0 + n) * K + k0 + 8 * cch) = o; }
    LDS_WAIT(); asm volatile("" ::: "memory");
}

DI void f8_item_load(const float* W, int N, int item, int lane, float (&wv)[32]) {
    const int nblk = N / 32, kb = item / nblk, nb = item % nblk, k0 = 64 * kb, n0 = 32 * nb;
#pragma unroll
    for (int i = 0; i < 32; ++i) wv[i] = W[(size_t)(k0 + 2 * i + (lane >> 5)) * N + n0 + (lane & 31)];
}
DI void f8_item_finish(const float (&wv)[32], int K, int N, unsigned char* WT, LAS float* scr, int item, int lane) {
    const int nblk = N / 32, kb = item / nblk, nb = item % nblk, k0 = 64 * kb, n0 = 32 * nb;
#pragma unroll
    for (int i = 0; i < 32; ++i) scr[(2 * i + (lane >> 5)) * 33 + (lane & 31)] = wv[i];
    LDS_WAIT(); asm volatile("" ::: "memory");
    const int cch = lane & 3;
#pragma unroll
    for (int j = 0; j < 2; ++j) { const int n = (lane >> 2) + 16 * j; const LAS float* s = scr + (16 * cch) * 33 + n;
        u32x4 o;
        o.x = pk4_fp8(32.f * s[0 * 33], 32.f * s[1 * 33], 32.f * s[2 * 33], 32.f * s[3 * 33]);
        o.y = pk4_fp8(32.f * s[4 * 33], 32.f * s[5 * 33], 32.f * s[6 * 33], 32.f * s[7 * 33]);
        o.z = pk4_fp8(32.f * s[8 * 33], 32.f * s[9 * 33], 32.f * s[10 * 33], 32.f * s[11 * 33]);
        o.w = pk4_fp8(32.f * s[12 * 33], 32.f * s[13 * 33], 32.f * s[14 * 33], 32.f * s[15 * 33]);
        *(u32x4*)(WT + (size_t)(n0 + n) * K + k0 + 16 * cch) = o; }
    LDS_WAIT(); asm volatile("" ::: "memory");
}
DI void transpose_item_f8(const float* W, int K, int N, unsigned char* WT, LAS float* scr, int item, int lane) {
    float wv[32];
    f8_item_load(W, N, item, lane, wv);
    f8_item_finish(wv, K, N, WT, scr, item, lane);
}

DI void p0a_tables(const Ctx& c) {
    float* sct = (float*)(c.ws + WS_SCT);
    const int gt = c.blk * NTHREADS + c.tid, NGT = c.G * NTHREADS;
    for (int i = gt; i < 33 * 1024; i += NGT) { const int b = i >> 10, k = i & 1023;
        const float v = b < 32 ? c.in(I_C)[b * 1024 + k] : c.in(I_CCTX)[k];
        sct[k * 40 + b] = v / (1.0f + __expf(-v)); }
    float* rope = (float*)(c.ws + WS_ROPE);
    for (int i = gt; i < 64 * 16; i += NGT) { const int pos = i >> 4, f = i & 15;
        const float inv = exp2f(-(float)f * (13.287712379549449f / 16.0f));
        const float ang = (float)pos * inv; rope[2 * i] = __cosf(ang); rope[2 * i + 1] = __sinf(ang); }
    if (c.blk == 0 && c.wave == 0) {
        const float* dl = c.in(I_DLAM);
        const float a = wave_sum(dl[c.lane] * dl[64 + c.lane]), b = wave_sum(dl[128 + c.lane] * dl[192 + c.lane]);
        if (c.lane == 0) ((float*)c.misc())[MW_LAM] = __expf(a) - __expf(b) + 0.2f;
    }
}

DI void modvec_item(const Ctx& c, int item) {
    const int l = item / 96, cg = item % 96, col = cg * 64 + c.lane;
    const float* W = c.in(I_ADAW) + (size_t)l * 1024 * 6144 + col;
    const float* sct = (const float*)(c.ws + WS_SCT);
    float acc[33];
#pragma unroll
    for (int b = 0; b < 33; ++b) acc[b] = 0.f;
    const int k0 = c.wave * 128;
#pragma unroll 1
    for (int kk0 = 0; kk0 < 128; kk0 += 32) {
        float wv[32];
#pragma unroll
        for (int i = 0; i < 32; ++i) wv[i] = W[(size_t)(k0 + kk0 + i) * 6144];
#pragma unroll
        for (int g = 0; g < 8; ++g) {
#pragma unroll
            for (int i = 0; i < 4; ++i) { const float* s = sct + (k0 + kk0 + 4 * g + i) * 40;
#pragma unroll
                for (int b = 0; b < 33; ++b) acc[b] = fmaf(s[b], wv[4 * g + i], acc[b]); }
            __builtin_amdgcn_sched_barrier(0);
        }
    }
    LAS float* red = (LAS float*)c.lds;
#pragma unroll
    for (int b = 0; b < 33; ++b) red[(c.wave * 33 + b) * 64 + c.lane] = acc[b];
    __syncthreads();
    for (int o = c.tid; o < 33 * 64; o += NTHREADS) { const int b = o >> 6, cc = o & 63; float s = 0.f;
#pragma unroll
        for (int w = 0; w < 8; ++w) s += red[(w * 33 + b) * 64 + cc];
        c.mod(l, b)[cg * 64 + cc] = s + c.in(I_ADAB)[l * 6144 + cg * 64 + cc]; }
    __syncthreads();
}

DI void p0b_weights(const Ctx& c) {
    for (int it = c.blk; it < 192; it += c.G) modvec_item(c, it);
    LAS float* scr = (LAS float*)(c.lds + c.wave * 16384);
    const int I_IN = 16 * 62, I_QB = 4 * 24, I_KVB = 2 * 32, I_OUT = 16 * 32, I_QKV = 16 * 96, I_NAO = 16 * 32, I_R = 2 * 16, I_1 = 64 * 16 * 64, I_2 = 64 * 16 * 32;
    const int NIT = I_IN + I_QB + I_KVB + I_OUT + I_QKV + I_NAO + I_R + I_1 + I_2;
    unsigned char* ws = c.ws;
    int it = c.gw;
    { const int I_12 = I_1 + I_2;
      const float* w1 = c.in(I_W1); const float* w2 = c.in(I_W2);
      auto src = [&](int r, const float*& W, int& N, unsigned char*& WT, int& q) {
          if (r < I_1) { const int mtx = r >> 10; q = r & 1023; W = w1 + (size_t)mtx * 1024 * 2048; N = 2048; WT = ws + WS_W1 + (size_t)mtx * 2048 * 1024; }
          else { r -= I_1; const int mtx = r >> 9; q = r & 511; W = w2 + (size_t)mtx * 1024 * 1024; N = 1024; WT = ws + WS_W2 + (size_t)mtx * 1024 * 1024; } };
      float nv[32]; const float* W; int N, q; unsigned char* WT;
      if (it < I_12) { src(it, W, N, WT, q); f8_item_load(W, N, q, c.lane, nv); }
#pragma unroll 1
      for (; it < I_12; it += c.NGW) {
          float wv[32];
#pragma unroll
          for (int i = 0; i < 32; ++i) wv[i] = nv[i];
          const int cN = N, cq = q; unsigned char* const cWT = WT;
          if (it + c.NGW < I_12) { src(it + c.NGW, W, N, WT, q); f8_item_load(W, N, q, c.lane, nv); }
          f8_item_finish(wv, 1024, cN, cWT, scr, cq, c.lane);
      } }
    for (; it < NIT; it += c.NGW) {
        int r = it - (I_1 + I_2);
        if (r < I_IN) { transpose_item_f8(c.in(I_EWIN), 1024, EVEN_IN_W, ws + WS_WIN, scr, r, c.lane); continue; } r -= I_IN;
        if (r < I_QB) { transpose_item(c.in(I_WQB), 256, 768, (bf16_t*)(ws + WS_WQB), 0, scr, r, c.lane); continue; } r -= I_QB;
        if (r < I_KVB) { transpose_item(c.in(I_WKVB), 128, 1024, (bf16_t*)(ws + WS_WKVB), 0, scr, r, c.lane); continue; } r -= I_KVB;
        if (r < I_OUT) { transpose_item(c.in(I_EWOUT), 1024, 1024, (bf16_t*)(ws + WS_WOUT), 0, scr, r, c.lane); continue; } r -= I_OUT;
        if (r < I_QKV) { transpose_item_f8(c.in(I_NAQKV), 1024, 3072, ws + WS_WQKV, scr, r, c.lane); continue; } r -= I_QKV;
        if (r < I_NAO) { transpose_item(c.in(I_NAWOUT), 1024, 1024, (bf16_t*)(ws + WS_WNAO), 0, scr, r, c.lane); continue; } r -= I_NAO;
        { const int l = r >> 4, q = r & 15; transpose_item(c.in(I_RW) + (size_t)l * 1024 * 32, 1024, 32, (bf16_t*)(ws + WS_WR) + (size_t)l * 256 * 1024, 0, scr, q, c.lane); }
    }
    const int gt = c.blk * NTHREADS + c.tid, NGT = c.G * NTHREADS;
    { u32x4* p = (u32x4*)(ws + WS_WIN + (size_t)EVEN_IN_W * 1024); for (int i = gt; i < 64 * 1024 / 16; i += NGT) p[i] = (u32x4){0u, 0u, 0u, 0u}; }
    for (int l = 0; l < 2; ++l) { u32x4* p = (u32x4*)((bf16_t*)(ws + WS_WR) + (size_t)l * 256 * 1024 + 32 * 1024); for (int i = gt; i < 224 * 1024 / 8; i += NGT) p[i] = (u32x4){0u, 0u, 0u, 0u}; }
}

DI void load_row_f32(const float* p, int lane, f32x4 (&v)[4]) {
#pragma unroll
    for (int j = 0; j < 4; ++j) v[j] = ((const f32x4*)p)[lane + 64 * j];
}
DI void load_row_bf16(const bf16_t* p, int lane, f32x4 (&v)[4]) {
#pragma unroll
    for (int j = 0; j < 4; ++j) { const u32x2 w = ((const u32x2*)p)[lane + 64 * j]; v[j] = (f32x4){bflo(w.x), bfhi(w.x), bflo(w.y), bfhi(w.y)}; }
}
DI void store_row_bf16(bf16_t* p, int lane, const f32x4 (&v)[4]) {
#pragma unroll
    for (int j = 0; j < 4; ++j) { u32x2 w; w.x = pk2(v[j][0], v[j][1]); w.y = pk2(v[j][2], v[j][3]); ((u32x2*)p)[lane + 64 * j] = w; }
}
DI float row_rstd(const f32x4 (&v)[4]) {
    float s = 0.f;
#pragma unroll
    for (int j = 0; j < 4; ++j) s += (v[j][0] * v[j][0] + v[j][1] * v[j][1]) + (v[j][2] * v[j][2] + v[j][3] * v[j][3]);
    return __builtin_amdgcn_rsqf(wave_sum(s) * (1.0f / DM) + EPS);
}
DI void norm_mod_store(const f32x4 (&x)[4], const float* g, const float* shift, const float* scale, bf16_t* dst, int lane, unsigned char* dst8 = nullptr) {
    const float rstd = row_rstd(x); f32x4 h[4];
#pragma unroll
    for (int j = 0; j < 4; ++j) { const f32x4 gg = ((const f32x4*)g)[lane + 64 * j], sh = ((const f32x4*)shift)[lane + 64 * j], sc = ((const f32x4*)scale)[lane + 64 * j];
        h[j] = x[j] * rstd * gg * (sc + 1.0f) + sh; }
    if (dst) store_row_bf16(dst, lane, h);
    if (dst8) {
#pragma unroll
        for (int j = 0; j < 4; ++j) ((unsigned*)dst8)[lane + 64 * j] = pk4_fp8(h[j][0], h[j][1], h[j][2], h[j][3]); }
}

DI void norm_mod_store_lds(const f32x4 (&x)[4], const LAS float* g, const LAS float* shift, const LAS float* scale, int lane, unsigned char* dst8) {
    f32x4 qg[4], qh[4], qc[4];
#pragma unroll
    for (int j = 0; j < 4; ++j) { qg[j] = ((const LAS f32x4*)g)[lane + 64 * j]; qh[j] = ((const LAS f32x4*)shift)[lane + 64 * j]; qc[j] = ((const LAS f32x4*)scale)[lane + 64 * j]; }
    __builtin_amdgcn_sched_barrier(0);
    const float rstd = row_rstd(x);
#pragma unroll
    for (int j = 0; j < 4; ++j) { const f32x4 h = x[j] * rstd * qg[j] * (qc[j] + 1.0f) + qh[j];
        ((unsigned*)dst8)[lane + 64 * j] = pk4_fp8(h[0], h[1], h[2], h[3]); }
}
DI void p_prenorm0(const Ctx& c) {
    const int per = (((TT + c.G - 1) / c.G) + 7) & ~7, base = c.blk * per, t0 = base + c.wave, nk = per >> 3;
    LAS float* Pm = (LAS float*)c.lds;
    const int b0 = mod_idx(min(base, TT - 1)), b1 = mod_idx(min(base + per - 1, TT - 1));
    { const float* g = c.in(I_MIXPRE); const float* m0 = c.mod(0, b0); const float* m1 = c.mod(0, b1);
      for (int i = c.tid; i < 1024; i += NTHREADS) { Pm[i] = g[i]; Pm[1024 + i] = m0[i]; Pm[2048 + i] = m0[1024 + i]; Pm[3072 + i] = m1[i]; Pm[4096 + i] = m1[1024 + i]; } }
    __syncthreads();
    f32x4 nx[4][4];
#pragma unroll
    for (int r = 0; r < 4; ++r) load_row_f32(xin_row(c, min(t0 + 8 * r, TT - 1)), c.lane, nx[r]);
#pragma unroll 1
    for (int k = 0;; k += 4) {
        f32x4 x[4][4];
#pragma unroll
        for (int r = 0; r < 4; ++r)
#pragma unroll
            for (int j = 0; j < 4; ++j) x[r][j] = nx[r][j];
        if (k + 4 < nk) {
#pragma unroll
            for (int r = 0; r < 4; ++r) load_row_f32(xin_row(c, min(t0 + 8 * (k + 4 + r), TT - 1)), c.lane, nx[r]); }
#pragma unroll
        for (int r = 0; r < 4; ++r) { const int m = t0 + 8 * (k + r); if (k + r < nk && m < TT) { const LAS float* ms = Pm + 1024 + (mod_idx(m) == b0 ? 0 : 2048);
            norm_mod_store_lds(x[r], Pm, ms, ms + 1024, c.lane, c.ws + WS_H8 + (size_t)m * DM); } }
        if (k + 4 >= nk) break;
    }
}

DI void postmix_row(const Ctx& c, int l, int m, const f32x4 (&y)[4], f32x4 (&x)[4]) {
    const float* md = c.mod(l, mod_idx(m));
    const float rstd = row_rstd(y);
    const float* g = c.in(I_MIXPOST) + l * DM;
#pragma unroll
    for (int j = 0; j < 4; ++j) { const f32x4 gg = ((const f32x4*)g)[c.lane + 64 * j], gate = ((const f32x4*)(md + 2048))[c.lane + 64 * j];
        x[j] = x[j] + gate * (y[j] * rstd * gg); }
    float* xo = xrow(c, m);
#pragma unroll
    for (int j = 0; j < 4; ++j) ((f32x4*)xo)[c.lane + 64 * j] = x[j];
    norm_mod_store(x, c.in(I_FFNPRE) + l * DM, md + 3 * 1024, md + 4 * 1024, c.H() + (size_t)m * DM, c.lane, c.ws + WS_H8 + (size_t)m * DM);
}
DI void p_postmix(const Ctx& c, int l, int nrows) {
    const bf16_t* Y = c.r<bf16_t>(R_Y);
    for (int m0 = c.gw; m0 < nrows; m0 += 2 * c.NGW) {
        const int m1 = m0 + c.NGW; const bool ok1 = m1 < nrows;
        f32x4 y0[4], x0[4], y1[4], x1[4];
        load_row_bf16(Y + (size_t)m0 * DM, c.lane, y0);
        if (l == 0) load_row_f32(xin_row(c, m0), c.lane, x0); else load_row_f32(xrow(c, m0), c.lane, x0);
        if (ok1) { load_row_bf16(Y + (size_t)m1 * DM, c.lane, y1);
            if (l == 0) load_row_f32(xin_row(c, m1), c.lane, x1); else load_row_f32(xrow(c, m1), c.lane, x1); }
        postmix_row(c, l, m0, y0, x0);
        if (ok1) postmix_row(c, l, m1, y1, x1);
    }
}

struct FfnRow { unsigned e[4][4]; f32x4 x[4]; u32x2 y[4]; f32x4 tw; };
DI void postffn_load(const Ctx& c, int l, int m, const u32x4 sl, FfnRow& R) {
    const unsigned char* EO = c.r<unsigned char>(R_EO);
    R.tw = *(const f32x4*)(c.r<float>(R_TOPW) + (size_t)m * 4);
    const unsigned s[4] = {sl.x, sl.y, sl.z, sl.w};
#pragma unroll
    for (int k = 0; k < 4; ++k)
#pragma unroll
        for (int j = 0; j < 4; ++j) R.e[k][j] = ((const unsigned*)(EO + (size_t)s[k] * DM))[c.lane + 64 * j];
    if (l == 0) load_row_f32(xin_row(c, m), c.lane, R.x); else load_row_f32(xrow(c, m), c.lane, R.x);
    { const u32x2* yp = (const u32x2*)(c.r<bf16_t>(R_Y) + (size_t)m * DM);
#pragma unroll
      for (int j = 0; j < 4; ++j) R.y[j] = yp[c.lane + 64 * j]; }
}
DI void postffn_row(const Ctx& c, int l, int m, bool last, FfnRow& R, const LAS float* Pm, int b0) {
    f32x4 y[4];
#pragma unroll
    for (int j = 0; j < 4; ++j) { y[j] = (f32x4){0.f, 0.f, 0.f, 0.f};
#pragma unroll
        for (int k = 0; k < 4; ++k) { const unsigned w = R.e[k][j]; const f32x2 lo = __builtin_amdgcn_cvt_pk_f32_fp8((int)w, false), hi = __builtin_amdgcn_cvt_pk_f32_fp8((int)w, true);
            y[j] += (f32x4){lo.x, lo.y, hi.x, hi.y} * R.tw[k]; } }
    const LAS float* ms = Pm + 3072 + (mod_idx(m) == b0 ? 0 : 4096);
    {
        f32x4 ym[4], mg[4], mt[4];
#pragma unroll
        for (int j = 0; j < 4; ++j) { mg[j] = ((const LAS f32x4*)(Pm + 2048))[c.lane + 64 * j]; mt[j] = ((const LAS f32x4*)(ms + 3072))[c.lane + 64 * j]; }
#pragma unroll
        for (int j = 0; j < 4; ++j) ym[j] = (f32x4){bflo(R.y[j].x), bfhi(R.y[j].x), bflo(R.y[j].y), bfhi(R.y[j].y)};
        const float rsy = row_rstd(ym);
#pragma unroll
        for (int j = 0; j < 4; ++j) R.x[j] = R.x[j] + mt[j] * (ym[j] * rsy * mg[j]);
    }
    f32x4 pg[4], pt[4];
#pragma unroll
    for (int j = 0; j < 4; ++j) { pg[j] = ((const LAS f32x4*)Pm)[c.lane + 64 * j]; pt[j] = ((const LAS f32x4*)ms)[c.lane + 64 * j]; }
    __builtin_amdgcn_sched_barrier(0);
    const float rstd = row_rstd(y);
#pragma unroll
    for (int j = 0; j < 4; ++j) R.x[j] = R.x[j] + pt[j] * (y[j] * rstd * pg[j]);
    if (last || m < TL) {
        float* xo = xrow(c, m);
#pragma unroll
        for (int j = 0; j < 4; ++j) ((f32x4*)xo)[c.lane + 64 * j] = R.x[j]; }
    if (!last) norm_mod_store_lds(R.x, Pm + 1024, ms + 1024, ms + 2048, c.lane, c.ws + WS_H8 + (size_t)m * DM);
}
DI void p_postffn(const Ctx& c, int l, int nrows, bool last) {
    const unsigned* slot = c.r<unsigned>(R_SLOT);
    const int per = (((nrows + c.G - 1) / c.G) + 7) & ~7, base = c.blk * per, t0 = base + c.wave, nk = per >> 3, lastrow = nrows - 1;
    LAS float* Pm = (LAS float*)c.lds;
    const int b0 = mod_idx(min(base, lastrow)), b1 = mod_idx(min(base + per - 1, lastrow));
    { const float* g = c.in(I_FFNPOST) + l * DM; const float* gn = c.in(I_MIXPRE) + (last ? l : l + 1) * DM; const float* gm = c.in(I_MIXPOST) + l * DM;
      for (int i = c.tid; i < 1024; i += NTHREADS) { Pm[i] = g[i]; Pm[1024 + i] = gn[i]; Pm[2048 + i] = gm[i];
#pragma unroll
          for (int s = 0; s < 2; ++s) { const int bs = s ? b1 : b0; const float* md = c.mod(l, bs); Pm[3072 + 4096 * s + i] = md[5 * 1024 + i]; Pm[3072 + 4096 * s + 3072 + i] = md[2 * 1024 + i];
              if (!last) { const float* md1 = c.mod(l + 1, bs); Pm[3072 + 4096 * s + 1024 + i] = md1[i]; Pm[3072 + 4096 * s + 2048 + i] = md1[1024 + i]; } } } }
    __syncthreads();
    auto ldslot = [&](int k) { return *(const u32x4*)(slot + (size_t)min(t0 + 8 * k, lastrow) * 4); };
    FfnRow A, B;
    u32x4 nsA, nsB;
    { const u32x4 s0 = ldslot(0), s1 = ldslot(1); nsA = ldslot(2); nsB = ldslot(3);
      postffn_load(c, l, min(t0, lastrow), s0, A); postffn_load(c, l, min(t0 + 8, lastrow), s1, B); }
#pragma unroll 1
    for (int k = 0;; k += 2) {
        const int m0 = t0 + 8 * k, m1 = m0 + 8;
        const u32x4 fsA = ldslot(k + 4), fsB = ldslot(k + 5);
        FfnRow A2, B2;
        postffn_load(c, l, min(m0 + 16, lastrow), nsA, A2); postffn_load(c, l, min(m0 + 24, lastrow), nsB, B2);
        if (m0 < nrows) postffn_row(c, l, m0, last, A, Pm, b0);
        if (k + 1 < nk && m1 < nrows) postffn_row(c, l, m1, last, B, Pm, b0);
        if (k + 2 >= nk) break;
        A = A2; B = B2; nsA = fsA; nsB = fsB;
    }
}

template <typename CS>
DI void rope8(f32x4& lo, f32x4& hi, const float (&plo)[8], const float (&phi)[8], bool upper, CS cs) {
    float v[8] = {lo[0], lo[1], lo[2], lo[3], hi[0], hi[1], hi[2], hi[3]};
#pragma unroll
    for (int e = 0; e < 8; ++e) { const float co = cs[2 * e], si = cs[2 * e + 1]; const float p = e < 4 ? plo[e] : phi[e];
        v[e] = upper ? (v[e] * co + p * si) : (v[e] * co - p * si); }
    lo = (f32x4){v[0], v[1], v[2], v[3]}; hi = (f32x4){v[4], v[5], v[6], v[7]};
}
DI void p_even_post_inproj(const Ctx& c) {
    bf16_t* P = c.r<bf16_t>(R_P); bf16_t* CQN = c.r<bf16_t>(R_CQN); bf16_t* CKVN = c.r<bf16_t>(R_CKVN); bf16_t* KVX = c.r<bf16_t>(R_KVX);
    LAS float* rope = (LAS float*)(c.lds + LDSCTL_OFF + 8192);
    { const f32x4* src = (const f32x4*)(c.ws + WS_ROPE); ((LAS f32x4*)rope)[c.tid] = src[c.tid]; }
    __syncthreads();
    const int lane = c.lane, a = lane & 7;
    const float* gp = lane < 32 ? c.in(I_QNG) + 8 * lane : c.in(I_KVNG) + 8 * ((lane - 32) & 15);
    const f32x4 g0 = *(const f32x4*)gp, g1 = *(const f32x4*)(gp + 4);
    const int n = c.gw < TT ? (TT - c.gw + c.NGW - 1) / c.NGW : 0;
    auto ld = [&](int k) { const int mm = min(c.gw + k * c.NGW, TT - 1); return ((const u32x4*)(P + (size_t)mm * EVEN_IN_PAD))[lane + 192]; };
    u32x4 wq[8];
#pragma unroll
    for (int i = 0; i < 8; ++i) wq[i] = ld(i);
#pragma unroll 1
    for (int k = 0; k < n; k += 8) {
#pragma unroll
      for (int i = 0; i < 8; ++i) {
        u32x4 w = wq[i]; wq[i] = ld(k + 8 + i);
        if (k + i >= n) continue;
        const int m = c.gw + (k + i) * c.NGW;
        const bool lat = m < TL; const int s = m & 2047, prow = s >> 6, pcol = s & 63;
        const int pos = (a < 4) ? prow : pcol; const bool upper = (a & 2) != 0;
        const LAS float* cs = rope + (pos * 16 + (a & 1) * 8) * 2;
        {
            f32x4 lo = {bflo(w.x), bfhi(w.x), bflo(w.y), bfhi(w.y)}, hi = {bflo(w.z), bfhi(w.z), bflo(w.w), bfhi(w.w)};
            float ss = (lo[0] * lo[0] + lo[1] * lo[1]) + (lo[2] * lo[2] + lo[3] * lo[3]) + (hi[0] * hi[0] + hi[1] * hi[1]) + (hi[2] * hi[2] + hi[3] * hi[3]);
            const float s16 = row16_sum(ss);
            float s32; { auto r = __builtin_amdgcn_permlane16_swap(__float_as_uint(s16), __float_as_uint(s16), false, false); s32 = __uint_as_float(r[0]) + __uint_as_float(r[1]); }
            float plo[8], phi[8];
#pragma unroll
            for (int e = 0; e < 4; ++e) { plo[e] = dppf<0x4E>(lo[e]); phi[4 + e] = dppf<0x4E>(hi[e]); plo[4 + e] = 0.f; phi[e] = 0.f; }
            if (lane < 32) {
                const float rstd = __builtin_amdgcn_rsqf(s32 * (1.0f / 256.0f) + EPS);
                u32x4 o; o.x = pk2(lo[0] * rstd * g0[0], lo[1] * rstd * g0[1]); o.y = pk2(lo[2] * rstd * g0[2], lo[3] * rstd * g0[3]);
                o.z = pk2(hi[0] * rstd * g1[0], hi[1] * rstd * g1[1]); o.w = pk2(hi[2] * rstd * g1[2], hi[3] * rstd * g1[3]);
                *(u32x4*)(CQN + (size_t)m * 256 + 8 * lane) = o;
            } else if (lane < 48) {
                const float rstd = __builtin_amdgcn_rsqf(s16 * (1.0f / 128.0f) + EPS);
                u32x4 o; o.x = pk2(lo[0] * rstd * g0[0], lo[1] * rstd * g0[1]); o.y = pk2(lo[2] * rstd * g0[2], lo[3] * rstd * g0[3]);
                o.z = pk2(hi[0] * rstd * g1[0], hi[1] * rstd * g1[1]); o.w = pk2(hi[2] * rstd * g1[2], hi[3] * rstd * g1[3]);
                *(u32x4*)(CKVN + (size_t)m * 128 + 8 * (lane - 32)) = o;
            } else if (lane < 56) {
                if (lat) { rope8(lo, hi, plo, phi, upper, cs); w.x = pk2(lo[0], lo[1]); w.y = pk2(lo[2], lo[3]); w.z = pk2(hi[0], hi[1]); w.w = pk2(hi[2], hi[3]); }
                bf16_t* kd = KVX + (size_t)m * 1280 + 128 + 8 * (lane - 48);
#pragma unroll
                for (int h = 0; h < 4; ++h) *(u32x4*)(kd + h * 320) = w;
            }
        }
      }
    }
}
DI void p_rope_qpe(const Ctx& c) {
    bf16_t* QM = c.r<bf16_t>(R_QM); const float* rope = (const float*)(c.ws + WS_ROPE);
    const int lane = c.lane, a = lane & 7, h = (lane >> 3) & 3, half = lane >> 5;
    for (int m2 = c.gw; m2 < TL / 2; m2 += c.NGW) {
        const int m = 2 * m2 + half, s = m & 2047, prow = s >> 6, pcol = s & 63;
        const int pos = (a < 4) ? prow : pcol; const bool upper = (a & 2) != 0;
        const float* cs = rope + (pos * 16 + (a & 1) * 8) * 2;
        u32x4* p = (u32x4*)(QM + (size_t)m * 768 + h * 192 + 128 + 8 * a);
        u32x4 w = *p;
        f32x4 lo = {bflo(w.x), bfhi(w.x), bflo(w.y), bfhi(w.y)}, hi = {bflo(w.z), bfhi(w.z), bflo(w.w), bfhi(w.w)};
        float plo[8], phi[8];
#pragma unroll
        for (int e = 0; e < 4; ++e) { plo[e] = dppf<0x4E>(lo[e]); phi[4 + e] = dppf<0x4E>(hi[e]); plo[4 + e] = 0.f; phi[e] = 0.f; }
        rope8(lo, hi, plo, phi, upper, cs);
        w.x = pk2(lo[0], lo[1]); w.y = pk2(lo[2], lo[3]); w.z = pk2(hi[0], hi[1]); w.w = pk2(hi[2], hi[3]);
        *p = w;
    }
}
DI void p_diff_merge(const Ctx& c) {
    const bf16_t* AO = c.r<bf16_t>(R_AO); bf16_t* AOM = c.r<bf16_t>(R_AOM);
    const float lam = ((const float*)c.misc())[MW_LAM];
    const f32x2 g = ((const f32x2*)c.in(I_SUBLN))[c.lane];
    const int step = 4 * c.NGW;
    int m0 = c.gw;
    if (m0 >= TT) return;
    unsigned nw[4][8];
#pragma unroll
    for (int r = 0; r < 4; ++r) { const unsigned* a = (const unsigned*)(AO + (size_t)min(m0 + r * c.NGW, TT - 1) * 1024);
#pragma unroll
        for (int q = 0; q < 8; ++q) nw[r][q] = a[q * 64 + c.lane]; }
#pragma unroll 1
    for (;; m0 += step) {
        unsigned w[4][8]; int mr[4];
#pragma unroll
        for (int r = 0; r < 4; ++r) { mr[r] = m0 + r * c.NGW;
#pragma unroll
            for (int q = 0; q < 8; ++q) w[r][q] = nw[r][q]; }
        if (m0 + step < TT) {
#pragma unroll
            for (int r = 0; r < 4; ++r) { const unsigned* a = (const unsigned*)(AO + (size_t)min(m0 + step + r * c.NGW, TT - 1) * 1024);
#pragma unroll
                for (int q = 0; q < 8; ++q) nw[r][q] = a[q * 64 + c.lane]; } }
#pragma unroll
        for (int r = 0; r < 4; ++r) if (mr[r] < TT) {
            unsigned o[4];
#pragma unroll
            for (int hd = 0; hd < 4; ++hd) { const unsigned w1 = w[r][2 * hd], w2 = w[r][2 * hd + 1];
                const float d0 = bflo(w1) - lam * bflo(w2), d1 = bfhi(w1) - lam * bfhi(w2);
                const float rstd = __builtin_amdgcn_rsqf(wave_sum(d0 * d0 + d1 * d1) * (1.0f / 128.0f) + EPS);
                o[hd] = pk2(d0 * rstd * g.x * 0.8f, d1 * rstd * g.y * 0.8f); }
            unsigned* dst = (unsigned*)(AOM + (size_t)mr[r] * 1024);
#pragma unroll
            for (int hd = 0; hd < 4; ++hd) dst[hd * 64 + c.lane] = o[hd];
        }
        if (m0 + step >= TT) break;
    }
}
namespace att {
constexpr int NW = 8, QBLK = 32, KVBLK = 64, DV = 128;
constexpr float THR = 8.f;
constexpr int SHM_V = KVBLK * DV * 2;
#define SBAR() __builtin_amdgcn_sched_barrier(0)
DI int crow(int r, int hi) { return (r & 3) + 8 * (r >> 2) + 4 * hi; }
DI int v_st(int k, int c) { const int kk = (k & ~0xC) | ((k & 4) << 1) | ((k & 8) >> 1); return ((kk >> 3) * 4 + (c >> 5)) * 512 + ((kk & 7) * 32 + (c & 31)) * 2; }
DI int v_rd_base(int lane) { return ((lane & 3) << 3) | (((lane >> 2) & 3) << 6) | (((lane >> 4) & 1) << 5) | (((lane >> 5) & 1) << 8); }
constexpr int v_rd_off(int d0, int ks, int half) { return d0 * 512 + ks * 4096 + half * 2048; }
template <int OFF> DI s16x4 tr_read(int vb) { s16x4 r; asm volatile("ds_read_b64_tr_b16 %0, %1 offset:%2" : "=&v"(r) : "v"(vb), "i"(OFF) : "memory"); return r; }
template <int D0> DI void pv_one(f32x16& od, int vb, bf16x8 pa0, bf16x8 pa1, bf16x8 pa2, bf16x8 pa3) {
    const s16x4 l0 = tr_read<v_rd_off(D0, 0, 0)>(vb), h0 = tr_read<v_rd_off(D0, 0, 1)>(vb), l1 = tr_read<v_rd_off(D0, 1, 0)>(vb), h1 = tr_read<v_rd_off(D0, 1, 1)>(vb);
    const s16x4 l2 = tr_read<v_rd_off(D0, 2, 0)>(vb), h2 = tr_read<v_rd_off(D0, 2, 1)>(vb), l3 = tr_read<v_rd_off(D0, 3, 0)>(vb), h3 = tr_read<v_rd_off(D0, 3, 1)>(vb);
    asm volatile("s_waitcnt lgkmcnt(0)" ::: "memory"); SBAR();
#define ATT_PK(L, H) (bf16x8){L[0], L[1], L[2], L[3], H[0], H[1], H[2], H[3]}
    od = __builtin_amdgcn_mfma_f32_32x32x16_bf16(pa0, ATT_PK(l0, h0), od, 0, 0, 0);
    od = __builtin_amdgcn_mfma_f32_32x32x16_bf16(pa1, ATT_PK(l1, h1), od, 0, 0, 0);
    od = __builtin_amdgcn_mfma_f32_32x32x16_bf16(pa2, ATT_PK(l2, h2), od, 0, 0, 0);
    od = __builtin_amdgcn_mfma_f32_32x32x16_bf16(pa3, ATT_PK(l3, h3), od, 0, 0, 0);
#undef ATT_PK
}
DI void pv_d0(f32x16* o, int vb, bf16x8 pa0, bf16x8 pa1, bf16x8 pa2, bf16x8 pa3) {
    pv_one<0>(o[0], vb, pa0, pa1, pa2, pa3); pv_one<1>(o[1], vb, pa0, pa1, pa2, pa3); pv_one<2>(o[2], vb, pa0, pa1, pa2, pa3); pv_one<3>(o[3], vb, pa0, pa1, pa2, pa3);
}
DI void partialSM(f32x16& p0, f32x16& p1, float& m_reg, float& mn, float& alpha, float C, float thr_raw) {
    float pmax = p0[0];
#pragma unroll
    for (int r = 1; r < 16; ++r) pmax = fmaxf(pmax, p0[r]);
#pragma unroll
    for (int r = 0; r < 16; ++r) pmax = fmaxf(pmax, p1[r]);
    { auto rr = __builtin_amdgcn_permlane32_swap(__float_as_uint(pmax), __float_as_uint(pmax), false, false);
      pmax = fmaxf(__uint_as_float(rr[0]), __uint_as_float(rr[1])); }
    if (__builtin_expect(__all(pmax - m_reg <= thr_raw), 1)) { mn = m_reg; alpha = 1.f; }
    else { mn = fmaxf(m_reg, pmax); alpha = __builtin_amdgcn_exp2f((m_reg - mn) * C); m_reg = mn; }
    const float mnC = -mn * C;
#pragma unroll
    for (int r = 0; r < 16; ++r) p0[r] = fmaf(p0[r], C, mnC);
#pragma unroll
    for (int r = 0; r < 16; ++r) p1[r] = fmaf(p1[r], C, mnC);
#pragma unroll
    for (int r = 0; r < 16; ++r) p0[r] = __builtin_amdgcn_exp2f(p0[r]);
}
DI void finishSM(f32x16& p0, f32x16& p1, float alpha, float& l_reg, bf16x8& pa0, bf16x8& pa1, bf16x8& pa2, bf16x8& pa3) {
#pragma unroll
    for (int r = 0; r < 16; ++r) p1[r] = __builtin_amdgcn_exp2f(p1[r]);
    float ps = 0;
#pragma unroll
    for (int r = 0; r < 16; ++r) ps += p0[r];
#pragma unroll
    for (int r = 0; r < 16; ++r) ps += p1[r];
    { auto rr = __builtin_amdgcn_permlane32_swap(__float_as_uint(ps), __float_as_uint(ps), false, false);
      ps = __uint_as_float(rr[0]) + __uint_as_float(rr[1]); }
    l_reg = l_reg * alpha + ps;
#define ATT_PK4(P, BASE, OUT) do { unsigned a0 = cvt_pk_bf16(P[BASE + 0], P[BASE + 1]), a1 = cvt_pk_bf16(P[BASE + 2], P[BASE + 3]);   \
    unsigned b0 = cvt_pk_bf16(P[BASE + 4], P[BASE + 5]), b1 = cvt_pk_bf16(P[BASE + 6], P[BASE + 7]);                              \
    auto r0 = __builtin_amdgcn_permlane32_swap(a0, b0, false, false); auto r1 = __builtin_amdgcn_permlane32_swap(a1, b1, false, false); \
    u32x4 w = {r0[0], r1[0], r0[1], r1[1]}; OUT = *reinterpret_cast<bf16x8*>(&w); } while (0)
    ATT_PK4(p0, 0, pa0); ATT_PK4(p0, 8, pa1); ATT_PK4(p1, 0, pa2); ATT_PK4(p1, 8, pa3);
#undef ATT_PK4
}

template <int DQK> struct Geo {
    static constexpr int PITCH = DQK * 2, SHM_K = KVBLK * PITCH, NCH = DQK / 8, KCH = (KVBLK * NCH) / 512, ND0 = DQK / 16;
    static constexpr int LDS_NEED = 2 * SHM_V + 2 * SHM_K + NW * 64 * 4;
};
template <int DQK> DI int kswz(int row, int colB) { return row * Geo<DQK>::PITCH + (colB ^ ((row & 7) << 4)); }

template <int DQK, int SD>
DI void attn_unit(const bf16_t* __restrict__ Qb, int ldq, const bf16_t* __restrict__ Kb, int ldk, const bf16_t* __restrict__ Vb, int ldv, bf16_t* __restrict__ Ob, int ldo,
                  int qrow0, int lat0, int nlat, int ctx0, int NT, float scale, char* lds, int tid) {
    using G = Geo<DQK>;
    constexpr int SHM_K = G::SHM_K, KCH = G::KCH, NCH = G::NCH, ND0 = G::ND0;
    const float C = scale * 1.4426950408889634f, thr_raw = THR / scale;
    const int wid = tid >> 6, lane = tid & 63, r32 = lane & 31, hi = lane >> 5;
    char* V_lds = lds; char* K_lds = lds + 2 * SHM_V;
    float* wsf = (float*)(lds + 2 * SHM_V + 2 * SHM_K) + wid * 64; float* li_l = wsf; float* al_l = wsf + 32;
    float m_reg = -1e30f, l_reg = 0; f32x16 o[4] = {}; bf16x8 qr[ND0];
    const bf16_t* Qw = Qb + (size_t)(qrow0 + wid * QBLK + r32) * ldq + hi * 8;
#pragma unroll
    for (int d0 = 0; d0 < ND0; ++d0) qr[d0] = *(const bf16x8*)(Qw + d0 * 16);
    const int sr = tid >> 4, sc = (tid & 15) * 8, vst0 = v_st(sr, sc), vst1 = v_st(32 + sr, sc);
    int krow_[KCH], kcol_[KCH];
#pragma unroll
    for (int i = 0; i < KCH; ++i) { const int g = tid + 512 * i; krow_[i] = g / NCH; kcol_[i] = (g % NCH) * 8; }
    const int vb0 = (int)(uintptr_t)V_lds + v_rd_base(lane);
    struct { bf16x8 vs0, vs1, ks[KCH]; } sr_[SD];
#define KROW0(kt) ((kt) < nlat ? lat0 + (kt) * KVBLK : ctx0 + ((kt) - nlat) * KVBLK)
#define SLOAD(i, kt) do { const int _k0 = KROW0(kt); sr_[i].vs0 = *(const bf16x8*)(Vb + (size_t)(_k0 + sr) * ldv + sc); sr_[i].vs1 = *(const bf16x8*)(Vb + (size_t)(_k0 + 32 + sr) * ldv + sc); \
    _Pragma("unroll") for (int _c = 0; _c < KCH; ++_c) sr_[i].ks[_c] = *(const bf16x8*)(Kb + (size_t)(_k0 + krow_[_c]) * ldk + kcol_[_c]); } while (0)
#define SWRITE(b, i) do { *(bf16x8*)(V_lds + (b) * SHM_V + vst0) = sr_[i].vs0; *(bf16x8*)(V_lds + (b) * SHM_V + vst1) = sr_[i].vs1; \
    _Pragma("unroll") for (int _c = 0; _c < KCH; ++_c) *(bf16x8*)(K_lds + (b) * SHM_K + kswz<DQK>(krow_[_c], kcol_[_c] * 2)) = sr_[i].ks[_c]; } while (0)
#define SWAIT() do { if constexpr (SD == 2) { if constexpr (KCH == 1) asm volatile("s_waitcnt vmcnt(3)" ::: "memory"); else asm volatile("s_waitcnt vmcnt(5)" ::: "memory"); } \
    else asm volatile("s_waitcnt vmcnt(0)" ::: "memory"); } while (0)
#define RESC(a) do { if (__any((a) < 1.f)) { if (hi == 0) al_l[r32] = (a); asm volatile("s_waitcnt lgkmcnt(0)" ::: "memory"); \
    _Pragma("unroll") for (int d = 0; d < 4; ++d) _Pragma("unroll") for (int r = 0; r < 16; ++r) o[d][r] *= al_l[crow(r, hi)]; } } while (0)
#define QKT(p0, p1, Ks) do { p0 = f32x16{}; p1 = f32x16{}; _Pragma("unroll") for (int d0 = 0; d0 < ND0; ++d0) { const int cb = (d0 * 16 + hi * 8) * 2; \
    const bf16x8 b0 = *(const bf16x8*)((Ks) + kswz<DQK>(r32, cb)); const bf16x8 b1 = *(const bf16x8*)((Ks) + kswz<DQK>(32 + r32, cb)); \
    p0 = __builtin_amdgcn_mfma_f32_32x32x16_bf16(b0, qr[d0], p0, 0, 0, 0); p1 = __builtin_amdgcn_mfma_f32_32x32x16_bf16(b1, qr[d0], p1, 0, 0, 0); } } while (0)
    f32x16 pA0, pA1, pB0, pB1; float mnA, mnB, alA, alB; bf16x8 pa0, pa1, pa2, pa3;
    constexpr int SE = 0, SO = SD - 1;
    SLOAD(SE, 0); asm volatile("s_waitcnt vmcnt(0)" ::: "memory"); SWRITE(0, SE); __syncthreads();
    QKT(pA0, pA1, K_lds); partialSM(pA0, pA1, m_reg, mnA, alA, C, thr_raw);
    SLOAD(SO, 1); if constexpr (SD == 2) { if (2 < NT) SLOAD(SE, 2); }
    SWAIT(); SWRITE(1, SO); __syncthreads();
    for (int j = 1; j + 1 < NT; j += 2) {
        SBAR(); QKT(pB0, pB1, K_lds + SHM_K);
        finishSM(pA0, pA1, alA, l_reg, pa0, pa1, pa2, pa3); SBAR();
        SLOAD(SO, j + SD); SBAR();
        pv_d0(o, vb0, pa0, pa1, pa2, pa3); partialSM(pB0, pB1, m_reg, mnB, alB, C, thr_raw);
        __syncthreads(); SWAIT(); SWRITE(0, SE);
        RESC(alB); __syncthreads();
        SBAR(); QKT(pA0, pA1, K_lds);
        finishSM(pB0, pB1, alB, l_reg, pa0, pa1, pa2, pa3); SBAR();
        if (SD == 1 || j + 3 < NT) SLOAD(SE, j + 1 + SD); SBAR();
        pv_d0(o, vb0 + SHM_V, pa0, pa1, pa2, pa3); partialSM(pA0, pA1, m_reg, mnA, alA, C, thr_raw);
        __syncthreads(); SWAIT(); SWRITE(1, SO);
        RESC(alA); __syncthreads();
    }
    SBAR(); QKT(pB0, pB1, K_lds + SHM_K);
    finishSM(pA0, pA1, alA, l_reg, pa0, pa1, pa2, pa3); SBAR();
    pv_d0(o, vb0, pa0, pa1, pa2, pa3); partialSM(pB0, pB1, m_reg, mnB, alB, C, thr_raw);
    __syncthreads(); RESC(alB);
    finishSM(pB0, pB1, alB, l_reg, pa0, pa1, pa2, pa3); SBAR();
    pv_d0(o, vb0 + SHM_V, pa0, pa1, pa2, pa3);
    if (hi == 0) li_l[r32] = l_reg; asm volatile("s_waitcnt lgkmcnt(0)" ::: "memory");
    float rli[16];
#pragma unroll
    for (int r = 0; r < 16; ++r) rli[r] = __builtin_amdgcn_rcpf(li_l[crow(r, hi)]);
    bf16_t* Ow = Ob + (size_t)(qrow0 + wid * QBLK) * ldo;
#pragma unroll
    for (int r = 0; r < 16; ++r) { const int orow = crow(r, hi);
#pragma unroll
        for (int d0 = 0; d0 < 4; ++d0) Ow[(size_t)orow * ldo + d0 * 32 + r32] = (bf16_t)f2bf(o[d0][r] * rli[r]); }
    __syncthreads();
#undef KROW0
#undef SLOAD
#undef SWRITE
#undef SWAIT
#undef RESC
#undef QKT
}

template <int DQK>
DI void attn_unit_dma(const bf16_t* __restrict__ Qb, int ldq, const bf16_t* __restrict__ Kb, int ldk, const bf16_t* __restrict__ Vb, int ldv, bf16_t* __restrict__ Ob, int ldo,
                      int qrow0, int lat0, int nlat, int ctx0, int NT, float scale, char* lds, int tid, const float* __restrict__ rope = nullptr) {
    using G = Geo<DQK>;
    constexpr int SHM_K = G::SHM_K, KCH = G::KCH, NCH = G::NCH, ND0 = G::ND0;
    const float C = scale * 1.4426950408889634f;
    const int wid = __builtin_amdgcn_readfirstlane(tid >> 6), lane = tid & 63, r32 = lane & 31, hi = lane >> 5;
    char* V_lds = lds; char* K_lds = lds + 2 * SHM_V;
    float* wsf = (float*)(lds + 2 * SHM_V + 2 * SHM_K) + wid * 64; float* li_l = wsf; float* al_l = wsf + 32;
    float m_reg = -1e30f, l_reg = 0; f32x16 o[4] = {}; bf16x8 qr[ND0];
    const bf16_t* Qw = Qb + (size_t)(qrow0 + wid * QBLK + r32) * ldq + hi * 8;
#pragma unroll
    for (int d0 = 0; d0 < ND0; ++d0) qr[d0] = *(const bf16x8*)(Qw + d0 * 16);
    if constexpr (DQK == 192) {
        if (rope != nullptr && nlat > 0) {
            const int sq = (qrow0 + wid * QBLK + r32) & (SEQ - 1);
#pragma unroll
            for (int hf = 0; hf < 2; ++hf) { const int pos = hf ? (sq & (GRIDW - 1)) : (sq >> 6);
                const float* cs = rope + (pos * 16 + hi * 8) * 2;
                bf16x8 x1 = qr[8 + 2 * hf], x2 = qr[9 + 2 * hf];
#pragma unroll
                for (int e = 0; e < 8; ++e) { const float a = __builtin_bit_cast(float, (unsigned)(unsigned short)x1[e] << 16), bb = __builtin_bit_cast(float, (unsigned)(unsigned short)x2[e] << 16);
                    const float co = cs[2 * e], si = cs[2 * e + 1];
                    x1[e] = (short)f2bf(a * co - bb * si); x2[e] = (short)f2bf(bb * co + a * si); }
                qr[8 + 2 * hf] = x1; qr[9 + 2 * hf] = x2; }
        }
    }
    int koff[KCH], voff[2];
#pragma unroll
    for (int i = 0; i < KCH; ++i) { const int p = tid + 512 * i, row = p / NCH, cp = p % NCH; koff[i] = row * ldk + ((cp ^ (row & 7)) << 3); }
#pragma unroll
    for (int i = 0; i < 2; ++i) { const int p = tid + 512 * i, st = p >> 5, rem = p & 31, kk = ((st >> 2) << 3) | (rem >> 2);
        const int k = (kk & ~0xC) | ((kk & 4) << 1) | ((kk & 8) >> 1); voff[i] = k * ldv + (st & 3) * 32 + (rem & 3) * 8; }
    const int vb0 = (int)(uintptr_t)V_lds + v_rd_base(lane);
    const LAS unsigned char* const ldsl = (const LAS unsigned char*)lds;
#define KROW0(kt) ((kt) < nlat ? lat0 + (kt) * KVBLK : ctx0 + ((kt) - nlat) * KVBLK)
#define DMA_TILE(kt, b) do { const int _k0 = KROW0(kt); const bf16_t* _kp = Kb + (size_t)_k0 * ldk; const bf16_t* _vp = Vb + (size_t)_k0 * ldv; \
    _Pragma("unroll") for (int _c = 0; _c < KCH; ++_c) __builtin_amdgcn_global_load_lds((const unsigned*)(_kp + koff[_c]), (LAS unsigned*)(ldsl + 2 * SHM_V + (b) * SHM_K + _c * 8192 + wid * 1024), 16, 0, 0); \
    _Pragma("unroll") for (int _c = 0; _c < 2; ++_c) __builtin_amdgcn_global_load_lds((const unsigned*)(_vp + voff[_c]), (LAS unsigned*)(ldsl + (b) * SHM_V + _c * 8192 + wid * 1024), 16, 0, 0); } while (0)
    DMA_TILE(0, 0);
    asm volatile("s_waitcnt vmcnt(0)" ::: "memory"); __syncthreads();
#pragma unroll 1
    for (int j = 0; j < NT; ++j) {
        const int bsel = j & 1; const char* Ks = K_lds + bsel * SHM_K;
        if (j + 1 < NT) DMA_TILE(j + 1, bsel ^ 1);
        f32x16 p0 = {}, p1 = {};
#pragma unroll
        for (int d0 = 0; d0 < ND0; ++d0) { const int cb = (d0 * 16 + hi * 8) * 2;
            const bf16x8 b0 = *(const bf16x8*)(Ks + kswz<DQK>(r32, cb)); const bf16x8 b1 = *(const bf16x8*)(Ks + kswz<DQK>(32 + r32, cb));
            p0 = __builtin_amdgcn_mfma_f32_32x32x16_bf16(b0, qr[d0], p0, 0, 0, 0); p1 = __builtin_amdgcn_mfma_f32_32x32x16_bf16(b1, qr[d0], p1, 0, 0, 0); }
        float mn, alpha; bf16x8 pa0, pa1, pa2, pa3;
        partialSM(p0, p1, m_reg, mn, alpha, C, 0.f);
        if (__any(alpha < 1.f)) { if (hi == 0) al_l[r32] = alpha; asm volatile("s_waitcnt lgkmcnt(0)" ::: "memory");
#pragma unroll
            for (int d = 0; d < 4; ++d)
#pragma unroll
                for (int r = 0; r < 16; ++r) o[d][r] *= al_l[crow(r, hi)]; }
        finishSM(p0, p1, alpha, l_reg, pa0, pa1, pa2, pa3); SBAR();
        pv_d0(o, vb0 + bsel * SHM_V, pa0, pa1, pa2, pa3);
        asm volatile("s_waitcnt vmcnt(0)" ::: "memory");
        __syncthreads();
    }
    if (hi == 0) li_l[r32] = l_reg; asm volatile("s_waitcnt lgkmcnt(0)" ::: "memory");
    float rli[16];
#pragma unroll
    for (int r = 0; r < 16; ++r) rli[r] = __builtin_amdgcn_rcpf(li_l[crow(r, hi)]);
    bf16_t* Ow = Ob + (size_t)(qrow0 + wid * QBLK) * ldo;
#pragma unroll
    for (int r = 0; r < 16; ++r) { const int orow = crow(r, hi);
#pragma unroll
        for (int d0 = 0; d0 < 4; ++d0) Ow[(size_t)orow * ldo + d0 * 32 + r32] = (bf16_t)f2bf(o[d0][r] * rli[r]); }
    asm volatile("s_waitcnt vmcnt(0)" ::: "memory"); __syncthreads();
#undef KROW0
#undef DMA_TILE
}

template <int DQK>
DI void attn_unit_pd(const bf16_t* __restrict__ Qb, int ldq, const bf16_t* __restrict__ Kb, int ldk, const bf16_t* __restrict__ Vb, int ldv, bf16_t* __restrict__ Ob, int ldo,
                     int qrow0, int lat0, int nlat, int ctx0, int NT, float scale, char* lds, int tid, const float* __restrict__ rope = nullptr) {
    using G = Geo<DQK>;
    constexpr int SHM_K = G::SHM_K, KCH = G::KCH, NCH = G::NCH, ND0 = G::ND0, TILE = SHM_V + SHM_K;
    const float C = scale * 1.4426950408889634f, thr_raw = THR / scale;
    const int wid = __builtin_amdgcn_readfirstlane(tid >> 6), lane = tid & 63, r32 = lane & 31, hi = lane >> 5;
    float* wsf = (float*)(lds + 3 * TILE) + wid * 64; float* li_l = wsf; float* al_l = wsf + 32;
    float m_reg = -1e30f, l_reg = 0; f32x16 o[4] = {}; bf16x8 qr[ND0];
    const bf16_t* Qw = Qb + (size_t)(qrow0 + wid * QBLK + r32) * ldq + hi * 8;
#pragma unroll
    for (int d0 = 0; d0 < ND0; ++d0) qr[d0] = *(const bf16x8*)(Qw + d0 * 16);
    if constexpr (DQK == 192) {
        if (rope != nullptr && nlat > 0) {
            const int sq = (qrow0 + wid * QBLK + r32) & (SEQ - 1);
#pragma unroll
            for (int hf = 0; hf < 2; ++hf) { const int pos = hf ? (sq & (GRIDW - 1)) : (sq >> 6);
                const float* cs = rope + (pos * 16 + hi * 8) * 2;
                bf16x8 x1 = qr[8 + 2 * hf], x2 = qr[9 + 2 * hf];
#pragma unroll
                for (int e = 0; e < 8; ++e) { const float a = __builtin_bit_cast(float, (unsigned)(unsigned short)x1[e] << 16), bb = __builtin_bit_cast(float, (unsigned)(unsigned short)x2[e] << 16);
                    const float co = cs[2 * e], si = cs[2 * e + 1];
                    x1[e] = (short)f2bf(a * co - bb * si); x2[e] = (short)f2bf(bb * co + a * si); }
                qr[8 + 2 * hf] = x1; qr[9 + 2 * hf] = x2; }
        }
    }
    int koff[KCH], voff[2];
#pragma unroll
    for (int i = 0; i < KCH; ++i) { const int p = tid + 512 * i, row = p / NCH, cp = p % NCH; koff[i] = row * ldk + ((cp ^ (row & 7)) << 3); }
#pragma unroll
    for (int i = 0; i < 2; ++i) { const int p = tid + 512 * i, st = p >> 5, rem = p & 31, kk = ((st >> 2) << 3) | (rem >> 2);
        const int k = (kk & ~0xC) | ((kk & 4) << 1) | ((kk & 8) >> 1); voff[i] = k * ldv + (st & 3) * 32 + (rem & 3) * 8; }
    const int vb0 = (int)(uintptr_t)lds + v_rd_base(lane);
    LAS unsigned char* const ldsl = (LAS unsigned char*)lds;
#define KROW0(kt) ((kt) < nlat ? lat0 + (kt) * KVBLK : ctx0 + ((kt) - nlat) * KVBLK)
#define PD_DMA(kt, bsel) do { const int _k0 = KROW0(kt); const bf16_t* _kp = Kb + (size_t)_k0 * ldk; const bf16_t* _vp = Vb + (size_t)_k0 * ldv; const int _bo = (bsel) * TILE; \
    _Pragma("unroll") for (int _c = 0; _c < KCH; ++_c) __builtin_amdgcn_global_load_lds((const unsigned*)(_kp + koff[_c]), (LAS unsigned*)(ldsl + _bo + SHM_V + _c * 8192 + wid * 1024), 16, 0, 0); \
    _Pragma("unroll") for (int _c = 0; _c < 2; ++_c) __builtin_amdgcn_global_load_lds((const unsigned*)(_vp + voff[_c]), (LAS unsigned*)(ldsl + _bo + _c * 8192 + wid * 1024), 16, 0, 0); } while (0)
#define PD_WAIT1() do { if constexpr (KCH == 1) asm volatile("s_waitcnt vmcnt(3)" ::: "memory"); else asm volatile("s_waitcnt vmcnt(5)" ::: "memory"); } while (0)
#define PD_WAIT2() do { if constexpr (KCH == 1) asm volatile("s_waitcnt vmcnt(6)" ::: "memory"); else asm volatile("s_waitcnt vmcnt(10)" ::: "memory"); } while (0)
#define PD_BAR() do { asm volatile("s_waitcnt lgkmcnt(0)" ::: "memory"); __builtin_amdgcn_s_barrier(); asm volatile("" ::: "memory"); } while (0)
#define PD_RESC(a) do { if (__any((a) < 1.f)) { if (hi == 0) al_l[r32] = (a); asm volatile("s_waitcnt lgkmcnt(0)" ::: "memory"); \
    _Pragma("unroll") for (int d = 0; d < 4; ++d) _Pragma("unroll") for (int r = 0; r < 16; ++r) o[d][r] *= al_l[crow(r, hi)]; } } while (0)
#define PD_QKT(p0, p1, bsel) do { const char* Ks = lds + (bsel) * TILE + SHM_V; p0 = f32x16{}; p1 = f32x16{}; _Pragma("unroll") for (int d0 = 0; d0 < ND0; ++d0) { const int cb = (d0 * 16 + hi * 8) * 2; \
    const bf16x8 b0 = *(const bf16x8*)(Ks + kswz<DQK>(r32, cb)); const bf16x8 b1 = *(const bf16x8*)(Ks + kswz<DQK>(32 + r32, cb)); \
    p0 = __builtin_amdgcn_mfma_f32_32x32x16_bf16(b0, qr[d0], p0, 0, 0, 0); p1 = __builtin_amdgcn_mfma_f32_32x32x16_bf16(b1, qr[d0], p1, 0, 0, 0); } } while (0)
    f32x16 pA0, pA1, pB0, pB1; float mnA, mnB, alA, alB; bf16x8 pa0, pa1, pa2, pa3;
    PD_DMA(0, 0); PD_DMA(1, 1); PD_DMA(2, 2);
    PD_WAIT2(); PD_BAR();
    PD_QKT(pA0, pA1, 0); partialSM(pA0, pA1, m_reg, mnA, alA, C, thr_raw);
    PD_WAIT1(); PD_BAR();
    int b0i = 0, b1i = 1, b2i = 2;
#pragma unroll 1
    for (int j = 1; j + 1 < NT; j += 2) {
        SBAR(); PD_QKT(pB0, pB1, b1i);
        finishSM(pA0, pA1, alA, l_reg, pa0, pa1, pa2, pa3); SBAR();
        pv_d0(o, vb0 + b0i * TILE, pa0, pa1, pa2, pa3); partialSM(pB0, pB1, m_reg, mnB, alB, C, thr_raw);
        PD_BAR();
        if (j + 2 < NT) PD_DMA(j + 2, b0i);
        PD_RESC(alB);
        if (j + 2 < NT) PD_WAIT1(); else asm volatile("s_waitcnt vmcnt(0)" ::: "memory");
        PD_BAR();
        SBAR(); PD_QKT(pA0, pA1, b2i);
        finishSM(pB0, pB1, alB, l_reg, pa0, pa1, pa2, pa3); SBAR();
        pv_d0(o, vb0 + b1i * TILE, pa0, pa1, pa2, pa3); partialSM(pA0, pA1, m_reg, mnA, alA, C, thr_raw);
        PD_BAR();
        if (j + 3 < NT) PD_DMA(j + 3, b1i);
        PD_RESC(alA);
        if (j + 3 < NT) PD_WAIT1(); else asm volatile("s_waitcnt vmcnt(0)" ::: "memory");
        PD_BAR();
        { const int t0 = b0i; b0i = b2i; b2i = b1i; b1i = t0; }
    }
    SBAR(); PD_QKT(pB0, pB1, b1i);
    finishSM(pA0, pA1, alA, l_reg, pa0, pa1, pa2, pa3); SBAR();
    pv_d0(o, vb0 + b0i * TILE, pa0, pa1, pa2, pa3); partialSM(pB0, pB1, m_reg, mnB, alB, C, thr_raw);
    PD_RESC(alB);
    finishSM(pB0, pB1, alB, l_reg, pa0, pa1, pa2, pa3); SBAR();
    pv_d0(o, vb0 + b1i * TILE, pa0, pa1, pa2, pa3);
    if (hi == 0) li_l[r32] = l_reg; asm volatile("s_waitcnt lgkmcnt(0)" ::: "memory");
    float rli[16];
#pragma unroll
    for (int r = 0; r < 16; ++r) rli[r] = __builtin_amdgcn_rcpf(li_l[crow(r, hi)]);
    bf16_t* Ow = Ob + (size_t)(qrow0 + wid * QBLK) * ldo;
#pragma unroll
    for (int r = 0; r < 16; ++r) { const int orow = crow(r, hi);
#pragma unroll
        for (int d0 = 0; d0 < 4; ++d0) Ow[(size_t)orow * ldo + d0 * 32 + r32] = (bf16_t)f2bf(o[d0][r] * rli[r]); }
    PD_BAR();
#undef KROW0
#undef PD_DMA
#undef PD_WAIT1
#undef PD_WAIT2
#undef PD_BAR
#undef PD_RESC
#undef PD_QKT
}
}
namespace na {
constexpr int TILE_B = 16384;
constexpr int NBUF = 4, BIAS_OFF = NBUF * TILE_B, BIAS_ROWS = 23, BIAS_B = BIAS_ROWS * 64 * 4, WS_OFF = BIAS_OFF + BIAS_B, LDS_NEED = WS_OFF + 8 * 256;
DI int kswz64(int row, int colB) { return row * 128 + (colB ^ ((row & 7) << 4)); }
template <int OFF> DI s16x4 trr(int vb) { s16x4 r; asm volatile("ds_read_b64_tr_b16 %0, %1 offset:%2" : "=&v"(r) : "v"(vb), "i"(OFF) : "memory"); return r; }
DI bf16x8 pk4(const f32x16& P, int base) {
    unsigned a0, a1, b0, b1;
    if (base == 0) { a0 = cvt_pk_bf16(P[0], P[1]); a1 = cvt_pk_bf16(P[2], P[3]); b0 = cvt_pk_bf16(P[4], P[5]); b1 = cvt_pk_bf16(P[6], P[7]); }
    else { a0 = cvt_pk_bf16(P[8], P[9]); a1 = cvt_pk_bf16(P[10], P[11]); b0 = cvt_pk_bf16(P[12], P[13]); b1 = cvt_pk_bf16(P[14], P[15]); }
    auto r0 = __builtin_amdgcn_permlane32_swap(a0, b0, false, false); auto r1 = __builtin_amdgcn_permlane32_swap(a1, b1, false, false);
    u32x4 w = {r0[0], r1[0], r0[1], r1[1]}; return __builtin_bit_cast(bf16x8, w);
}
#define NA_PK(L, H) (bf16x8){L[0], L[1], L[2], L[3], H[0], H[1], H[2], H[3]}
template <int S> DI void pv_step(f32x16 (&o)[2], int vb, bf16x8 pa) {
    const s16x4 l0 = trr<S * 2048>(vb), h0 = trr<S * 2048 + 1024>(vb), l1 = trr<S * 2048 + 512>(vb), h1 = trr<S * 2048 + 1024 + 512>(vb);
    asm volatile("s_waitcnt lgkmcnt(0)" ::: "memory"); __builtin_amdgcn_sched_barrier(0);
    o[0] = __builtin_amdgcn_mfma_f32_32x32x16_bf16(pa, NA_PK(l0, h0), o[0], 0, 0, 0);
    o[1] = __builtin_amdgcn_mfma_f32_32x32x16_bf16(pa, NA_PK(l1, h1), o[1], 0, 0, 0);
}

DI void na_unit(const bf16_t* __restrict__ QKV, const float* __restrict__ rpb, bf16_t* __restrict__ NAO, int unit, char* lds, int tid, bool build_table) {
    const int rg = unit & 7, h = (unit >> 3) & 15, b = unit >> 7;
    const int wid = __builtin_amdgcn_readfirstlane(tid >> 6), lane = tid & 63, r32 = lane & 31, hi = lane >> 5;
    const int r0 = rg * 4, rp = wid >> 2, n = wid & 3;
    const int rq = r0 + 2 * rp + (r32 >> 4), cq = 16 * n + (r32 & 15);
    const int cb = min(max(16 * n - 8, 0), 32), qs = min(max(cq - 8, 0), 48), rsq = min(max(rq - 4, 0), 24);
    const int kr_lo = min(max(r0 - 4, 0), 24), kr_hi = min(max(r0 - 1, 0), 24) + 7, nloc = kr_hi - kr_lo + 1, NT = nloc + 4;
    const int wlo = min(max(r0 + 2 * rp - 4, 0), 24), whi = min(max(r0 + 2 * rp - 3, 0), 24) + 7;
    LAS unsigned char* const ldsl = (LAS unsigned char*)lds;
    LAS float* const btab = (LAS float*)(ldsl + BIAS_OFF);
    float* wsf = (float*)(lds + WS_OFF) + wid * 64; float* li_l = wsf; float* al_l = wsf + 32;
    constexpr float L2E = 1.4426950408889634f, SC = 0.125f * L2E;
    if (build_table) { for (int i = tid; i < BIAS_ROWS * 64; i += NTHREADS) { const int dr = (i >> 6) - 4, idx = (i & 63) - 16;
        btab[i] = (dr >= 0 && dr < 15 && idx >= 0 && idx < 31) ? rpb[h * (15 * 31) + dr * 31 + idx] * L2E : 0.f; } }
    const size_t tq = (size_t)b * SEQ + rq * GRIDW + cq;
    bf16x8 qr[4];
#pragma unroll
    for (int d0 = 0; d0 < 4; ++d0) qr[d0] = *(const bf16x8*)(QKV + tq * 3072 + h * 64 + d0 * 16 + hi * 8);
    unsigned vmask = 0;
#pragma unroll
    for (int r = 0; r < 16; ++r) { const int kc = cb + att::crow(r, hi); vmask |= (kc >= qs && kc < qs + 16) ? (1u << r) : 0u; }
    const int blane = (7 + 4 - rq) * 64 + (cb + 4 * hi - cq + 15 + 16);
    const int krow_ = tid >> 3, koff = krow_ * 3072 + 1024 + h * 64 + (((tid & 7) ^ (krow_ & 7)) << 3);
    const int vst = tid >> 5, vrem = tid & 31, vkk = ((vst >> 1) << 3) | (vrem >> 2), vk = (vkk & ~0xC) | ((vkk & 4) << 1) | ((vkk & 8) >> 1);
    const int voff = vk * 3072 + 2048 + h * 64 + (vst & 1) * 32 + (vrem & 3) * 8;
    const int g8 = (cb >> 3) + hi, vba = (2 * (g8 >> 1)) * 1024 + (4 * (g8 & 1)) * 64 + (((lane >> 2) & 3) << 6) + ((lane & 3) << 3) + (((lane >> 4) & 1) << 5);
    const int lbase = (int)(uintptr_t)lds;
#define NA_TOK0(j) ((j) < nloc ? (size_t)b * SEQ + (size_t)(kr_lo + (j)) * GRIDW : (size_t)TL + (size_t)b * CTXL + (size_t)((j) - nloc) * 64)
#define NA_DMA(j) do { const bf16_t* _src = QKV + NA_TOK0(j) * 3072; const int _bo = ((j) & (NBUF - 1)) * TILE_B; \
    __builtin_amdgcn_global_load_lds((const unsigned*)(_src + koff), (LAS unsigned*)(ldsl + _bo + wid * 1024), 16, 0, 0); \
    __builtin_amdgcn_global_load_lds((const unsigned*)(_src + voff), (LAS unsigned*)(ldsl + _bo + 8192 + wid * 1024), 16, 0, 0); } while (0)
    float m_reg = -1e28f, l_reg = 0.f; f32x16 o[2] = {};
    __syncthreads();
    NA_DMA(0); NA_DMA(1); NA_DMA(2);
    asm volatile("s_waitcnt vmcnt(4) lgkmcnt(0)" ::: "memory"); __builtin_amdgcn_s_barrier(); asm volatile("" ::: "memory");
#pragma unroll 1
    for (int j = 0; j < NT; ++j) {
        if (j + 3 < NT) NA_DMA(j + 3);
        const int bo = (j & (NBUF - 1)) * TILE_B; const char* Ks = lds + bo;
        const bool local = j < nloc; const int kr = kr_lo + j;
        if (local) {
            if (kr >= wlo && kr <= whi) {
                f32x16 p0 = {};
#pragma unroll
                for (int d0 = 0; d0 < 4; ++d0) { const bf16x8 kf = *(const bf16x8*)(Ks + kswz64(cb + r32, (d0 * 16 + hi * 8) * 2)); p0 = __builtin_amdgcn_mfma_f32_32x32x16_bf16(kf, qr[d0], p0, 0, 0, 0); }
                const unsigned mk = ((unsigned)(kr - rsq) < 8u) ? vmask : 0u;
                const LAS float* bp = btab + (blane + kr * 64);
                float pmax = -1e30f;
#pragma unroll
                for (int r = 0; r < 16; ++r) { const float bias = bp[att::crow(r, 0)];
                    float v = fmaf(p0[r], SC, bias); v = ((mk >> r) & 1u) ? v : -1e30f; p0[r] = v; pmax = fmaxf(pmax, v); }
                { auto rr = __builtin_amdgcn_permlane32_swap(__float_as_uint(pmax), __float_as_uint(pmax), false, false); pmax = fmaxf(__uint_as_float(rr[0]), __uint_as_float(rr[1])); }
                const float mn = fmaxf(m_reg, pmax), alpha = __builtin_amdgcn_exp2f(m_reg - mn); m_reg = mn;
                float ps = 0.f;
#pragma unroll
                for (int r = 0; r < 16; ++r) { p0[r] = __builtin_amdgcn_exp2f(p0[r] - mn); ps += p0[r]; }
                { auto rr = __builtin_amdgcn_permlane32_swap(__float_as_uint(ps), __float_as_uint(ps), false, false); ps = __uint_as_float(rr[0]) + __uint_as_float(rr[1]); }
                l_reg = l_reg * alpha + ps;
                if (__any(alpha < 1.f)) { if (hi == 0) al_l[r32] = alpha; asm volatile("s_waitcnt lgkmcnt(0)" ::: "memory");
#pragma unroll
                    for (int d = 0; d < 2; ++d)
#pragma unroll
                        for (int r = 0; r < 16; ++r) o[d][r] *= al_l[att::crow(r, hi)]; }
                const bf16x8 pa0 = pk4(p0, 0), pa1 = pk4(p0, 8);
                __builtin_amdgcn_sched_barrier(0);
                const int vb = lbase + bo + 8192 + vba;
                pv_step<0>(o, vb, pa0); pv_step<1>(o, vb, pa1);
            }
        } else {
            f32x16 p0 = {}, p1 = {};
#pragma unroll
            for (int d0 = 0; d0 < 4; ++d0) { const int cbb = (d0 * 16 + hi * 8) * 2;
                const bf16x8 k0 = *(const bf16x8*)(Ks + kswz64(r32, cbb)), k1 = *(const bf16x8*)(Ks + kswz64(32 + r32, cbb));
                p0 = __builtin_amdgcn_mfma_f32_32x32x16_bf16(k0, qr[d0], p0, 0, 0, 0); p1 = __builtin_amdgcn_mfma_f32_32x32x16_bf16(k1, qr[d0], p1, 0, 0, 0); }
            float pmax = -1e30f;
#pragma unroll
            for (int r = 0; r < 16; ++r) { p0[r] *= SC; p1[r] *= SC; pmax = fmaxf(pmax, fmaxf(p0[r], p1[r])); }
            { auto rr = __builtin_amdgcn_permlane32_swap(__float_as_uint(pmax), __float_as_uint(pmax), false, false); pmax = fmaxf(__uint_as_float(rr[0]), __uint_as_float(rr[1])); }
            const float mn = fmaxf(m_reg, pmax), alpha = __builtin_amdgcn_exp2f(m_reg - mn); m_reg = mn;
            float ps = 0.f;
#pragma unroll
            for (int r = 0; r < 16; ++r) { p0[r] = __builtin_amdgcn_exp2f(p0[r] - mn); p1[r] = __builtin_amdgcn_exp2f(p1[r] - mn); ps += p0[r] + p1[r]; }
            { auto rr = __builtin_amdgcn_permlane32_swap(__float_as_uint(ps), __float_as_uint(ps), false, false); ps = __uint_as_float(rr[0]) + __uint_as_float(rr[1]); }
            l_reg = l_reg * alpha + ps;
            if (__any(alpha < 1.f)) { if (hi == 0) al_l[r32] = alpha; asm volatile("s_waitcnt lgkmcnt(0)" ::: "memory");
#pragma unroll
                for (int d = 0; d < 2; ++d)
#pragma unroll
                    for (int r = 0; r < 16; ++r) o[d][r] *= al_l[att::crow(r, hi)]; }
            const bf16x8 pa0 = pk4(p0, 0), pa1 = pk4(p0, 8), pa2 = pk4(p1, 0), pa3 = pk4(p1, 8);
            __builtin_amdgcn_sched_barrier(0);
            const int vb = lbase + bo + 8192 + hi * 256 + (((lane >> 2) & 3) << 6) + ((lane & 3) << 3) + (((lane >> 4) & 1) << 5);
            pv_step<0>(o, vb, pa0); pv_step<1>(o, vb, pa1); pv_step<2>(o, vb, pa2); pv_step<3>(o, vb, pa3);
        }
        if (j + 3 < NT) asm volatile("s_waitcnt vmcnt(4)" ::: "memory"); else if (j + 2 < NT) asm volatile("s_waitcnt vmcnt(2)" ::: "memory"); else asm volatile("s_waitcnt vmcnt(0)" ::: "memory");
        asm volatile("s_waitcnt lgkmcnt(0)" ::: "memory"); __builtin_amdgcn_s_barrier(); asm volatile("" ::: "memory");
    }
    if (hi == 0) li_l[r32] = l_reg; asm volatile("s_waitcnt lgkmcnt(0)" ::: "memory");
#pragma unroll
    for (int r = 0; r < 16; ++r) { const int qi = att::crow(r, hi); const float rl = __builtin_amdgcn_rcpf(li_l[qi]);
        const size_t tok = (size_t)b * SEQ + (size_t)(r0 + 2 * rp + (qi >> 4)) * GRIDW + 16 * n + (qi & 15);
        bf16_t* op = NAO + tok * 1024 + h * 64 + r32;
        op[0] = (bf16_t)f2bf(o[0][r] * rl); op[32] = (bf16_t)f2bf(o[1][r] * rl); }
#undef NA_TOK0
#undef NA_DMA
}
#undef NA_PK
}
DI void p_route_a(const Ctx& c, int l, int ntok) {
    const float* LG = c.r<float>(R_LG); float* TOPW = c.r<float>(R_TOPW); unsigned* EPOS = c.r<unsigned>(R_EPOS);
    LAS unsigned* lcnt = (LAS unsigned*)(c.lds + LDSCTL_OFF + 256); LAS unsigned* lbase = lcnt + 32;
    unsigned* gcnt = c.ctl() + CW_CNT + l * 32 * 64;
    if (c.tid < 64) lcnt[c.tid] = 0u;
    __syncthreads();
    const int per = (ntok + c.G - 1) / c.G, t0 = c.blk * per, t1 = min(t0 + per, ntok);
    const int e = c.lane & 31, half = c.lane >> 5;
    for (int p = t0 + 2 * c.wave; p < t1; p += 2 * NWAVES) {
        const int tok = p + half; const bool valid = tok < t1;
        float v = valid ? LG[(size_t)tok * 32 + e] : -3.0e38f;
        float tv[4]; int te[4];
#pragma unroll
        for (int k = 0; k < 4; ++k) {
            const float mx = half_max(v);
            const unsigned long long bal = __ballot(v == mx);
            const unsigned bits = (unsigned)(bal >> (32 * half));
            const int sel = __ffs(bits) - 1;
            tv[k] = mx; te[k] = sel;
            if (e == sel) v = -3.0e38f;
        }
        const float e1 = __expf(tv[1] - tv[0]), e2 = __expf(tv[2] - tv[0]), e3 = __expf(tv[3] - tv[0]);
        const float inv = 1.0f / (1.0f + e1 + e2 + e3);
        if (valid && e < 4) {
            const int ee = e == 0 ? te[0] : e == 1 ? te[1] : e == 2 ? te[2] : te[3];
            const float ww = (e == 0 ? 1.0f : e == 1 ? e1 : e == 2 ? e2 : e3) * inv;
            const unsigned lp = atomicAdd((unsigned*)&lcnt[ee], 1u);
            TOPW[(size_t)tok * 4 + e] = ww;
            EPOS[(size_t)tok * 4 + e] = ((unsigned)ee << 24) | lp;
        }
    }
    __syncthreads();
    if (c.tid < 32) lbase[c.tid] = __hip_atomic_fetch_add(gcnt + 64 * c.tid, lcnt[c.tid], __ATOMIC_RELAXED, __HIP_MEMORY_SCOPE_AGENT);
    __syncthreads();
}
DI void p_route_b(const Ctx& c, int l, int ntok) {
    const unsigned* EPOS = c.r<unsigned>(R_EPOS); unsigned* SLOT = c.r<unsigned>(R_SLOT); unsigned* ROWTOK = c.r<unsigned>(R_ROWTOK);
    LAS unsigned* lcnt = (LAS unsigned*)(c.lds + LDSCTL_OFF + 256); LAS unsigned* lbase = lcnt + 32; LAS unsigned* cnt = lcnt + 64; LAS unsigned* tstart = lcnt + 96;
    unsigned* gcnt = c.ctl() + CW_CNT + l * 32 * 64;
    if (c.tid < 32) cnt[c.tid] = __hip_atomic_load(gcnt + 64 * c.tid, __ATOMIC_RELAXED, __HIP_MEMORY_SCOPE_AGENT);
    __syncthreads();
    if (c.tid == 0) { unsigned s = 0; for (int e = 0; e < 32; ++e) { tstart[e] = s; s += (cnt[e] + 255u) >> 8; } tstart[32] = s; }
    __syncthreads();
    const int per = (ntok + c.G - 1) / c.G, t0 = c.blk * per, t1 = min(t0 + per, ntok);
    for (int i = 4 * t0 + c.tid; i < 4 * t1; i += NTHREADS) {
        const unsigned ep = EPOS[i], e = ep >> 24, lp = ep & 0xffffffu;
        const unsigned dest = tstart[e] * 256u + lbase[e] + lp;
        ROWTOK[dest] = (unsigned)(i >> 2); SLOT[i] = dest;
    }
    unsigned* mw = c.misc();
    if (c.blk < 32) {
        const unsigned e = c.blk, ts = tstart[e], te = tstart[e + 1], n = cnt[e];
        for (unsigned i = n + c.tid; i < (te - ts) * 256u; i += NTHREADS) ROWTOK[ts * 256u + i] = 0u;
        for (unsigned t = ts + c.tid; t < te; t += NTHREADS) ((int*)mw)[MW_TILEE + l * 2048 + t] = (int)e;
    }
    if (c.blk == 0 && c.tid == 0) mw[MW_NT + l] = tstart[32];
    __syncthreads();
}

DI void p_postmix_route(const Ctx& c, int l, int ntok) {
    const bf16_t* Y = c.r<bf16_t>(R_Y); float* TOPW = c.r<float>(R_TOPW); unsigned* EPOS = c.r<unsigned>(R_EPOS);
    LAS unsigned* lcnt = (LAS unsigned*)(c.lds + LDSCTL_OFF + 256); LAS unsigned* lbase = lcnt + 32;
    unsigned* gcnt = c.ctl() + CW_CNT + l * 32 * 64;
    LAS u32x4* bfr = (LAS u32x4*)c.lds;
    LAS unsigned char* stg = c.lds + 65536 + c.wave * 4096;
    if (c.tid < 64) lcnt[c.tid] = 0u;
    { const float* rw = c.in(I_RW) + (size_t)l * 1024 * 32;
      for (int i = c.tid; i < 32 * 2 * 64; i += NTHREADS) { const int s = i >> 7, nb = (i >> 6) & 1, ln = i & 63, e = (ln & 15) + 16 * nb, k0 = 32 * s + 8 * (ln >> 4);
          u32x4 w; w.x = pk2(rw[(k0 + 0) * 32 + e], rw[(k0 + 1) * 32 + e]); w.y = pk2(rw[(k0 + 2) * 32 + e], rw[(k0 + 3) * 32 + e]);
          w.z = pk2(rw[(k0 + 4) * 32 + e], rw[(k0 + 5) * 32 + e]); w.w = pk2(rw[(k0 + 6) * 32 + e], rw[(k0 + 7) * 32 + e]); bfr[i] = w; } }
    const int per = (ntok + c.G - 1) / c.G, t0 = c.blk * per, t1 = min(t0 + per, ntok);
    LAS float* Pm = (LAS float*)(c.lds + 98304);
    const int b0 = mod_idx(min(t0, ntok - 1)), b1 = mod_idx(max(min(t1, ntok) - 1, 0));
    { const float* g0 = c.in(I_MIXPOST) + l * DM; const float* g1 = c.in(I_FFNPRE) + l * DM; const float* m0 = c.mod(l, b0) + 2048; const float* m1 = c.mod(l, b1) + 2048;
      for (int i = c.tid; i < 1024; i += NTHREADS) { Pm[i] = g0[i]; Pm[1024 + i] = g1[i];
          Pm[2048 + i] = m0[i]; Pm[3072 + i] = m0[1024 + i]; Pm[4096 + i] = m0[2048 + i]; Pm[5120 + i] = m1[i]; Pm[6144 + i] = m1[1024 + i]; Pm[7168 + i] = m1[2048 + i]; } }
    __syncthreads();
    const int lane = c.lane, e = lane & 31, half = lane >> 5;
    const float rbias = c.in(I_RB)[l * 32 + e];
    u32x2 yrA[4], yrB[4], nyA[4], nyB[4]; f32x4 xA[4], xB[4], nxA[4], nxB[4];
    auto ldrows = [&](int mq, u32x2 (&ya)[4], f32x4 (&xa)[4], u32x2 (&yb)[4], f32x4 (&xb)[4]) {
        const int a = min(mq, t1 - 1), b = min(mq + 1, t1 - 1);
#pragma unroll
        for (int j = 0; j < 4; ++j) { ya[j] = ((const u32x2*)(Y + (size_t)a * DM))[lane + 64 * j]; yb[j] = ((const u32x2*)(Y + (size_t)b * DM))[lane + 64 * j]; }
        if (l == 0) { load_row_f32(xin_row(c, a), lane, xa); load_row_f32(xin_row(c, b), lane, xb); } else { load_row_f32(xrow(c, a), lane, xa); load_row_f32(xrow(c, b), lane, xb); }
    };
    int mA = t0 + 2 * c.wave;
    if (mA < t1) ldrows(mA, nyA, nxA, nyB, nxB);
#pragma unroll 1
    for (; mA < t1; mA += 2 * NWAVES) {
        const int mB = mA + 1; const bool okB = mB < t1;
        f32x4 yA[4], yB[4];
#pragma unroll
        for (int j = 0; j < 4; ++j) { yrA[j] = nyA[j]; yrB[j] = nyB[j]; xA[j] = nxA[j]; xB[j] = nxB[j]; }
        if (mA + 2 * NWAVES < t1) ldrows(mA + 2 * NWAVES, nyA, nxA, nyB, nxB);
#pragma unroll
        for (int j = 0; j < 4; ++j) { yA[j] = (f32x4){bflo(yrA[j].x), bfhi(yrA[j].x), bflo(yrA[j].y), bfhi(yrA[j].y)}; yB[j] = (f32x4){bflo(yrB[j].x), bfhi(yrB[j].x), bflo(yrB[j].y), bfhi(yrB[j].y)}; }
#pragma unroll
        for (int r = 0; r < 2; ++r) {
            if (r == 1 && !okB) break;
            const int m = r ? mB : mA; f32x4 (&y)[4] = r ? yB : yA; f32x4 (&x)[4] = r ? xB : xA;
            const LAS float* ms = Pm + 2048 + (mod_idx(m) == b0 ? 0 : 3072);
            f32x4 pg[4], pt[4];
#pragma unroll
            for (int j = 0; j < 4; ++j) { pg[j] = ((const LAS f32x4*)Pm)[lane + 64 * j]; pt[j] = ((const LAS f32x4*)ms)[lane + 64 * j]; }
            __builtin_amdgcn_sched_barrier(0);
            const float rstd = row_rstd(y);
#pragma unroll
            for (int j = 0; j < 4; ++j) x[j] = x[j] + pt[j] * (y[j] * rstd * pg[j]);
            f32x4 qg[4], qh[4], qc[4];
#pragma unroll
            for (int j = 0; j < 4; ++j) { qg[j] = ((const LAS f32x4*)(Pm + 1024))[lane + 64 * j]; qh[j] = ((const LAS f32x4*)(ms + 1024))[lane + 64 * j]; qc[j] = ((const LAS f32x4*)(ms + 2048))[lane + 64 * j]; }
            __builtin_amdgcn_sched_barrier(0);
            const float rs2 = row_rstd(x);
            unsigned* h8 = (unsigned*)(c.ws + WS_H8 + (size_t)m * DM);
#pragma unroll
            for (int j = 0; j < 4; ++j) {
                const f32x4 h = x[j] * rs2 * qg[j] * (qc[j] + 1.0f) + qh[j];
                h8[lane + 64 * j] = pk4_fp8(h[0], h[1], h[2], h[3]);
                u32x2 w; w.x = pk2(h[0], h[1]); w.y = pk2(h[2], h[3]); ((LAS u32x2*)(stg + r * 2048))[lane + 64 * j] = w; }
        }
        f32x4 acc0 = {0.f, 0.f, 0.f, 0.f}, acc1 = {0.f, 0.f, 0.f, 0.f};
        const LAS unsigned char* ap = stg + (lane & 1) * 2048 + (lane >> 4) * 16;
#pragma unroll 1
        for (int s0 = 0; s0 < 32; s0 += 4) {
            bf16x8 fa[4], fb0[4], fb1[4];
#pragma unroll
            for (int i = 0; i < 4; ++i) { const int s = s0 + i; fa[i] = *(const LAS bf16x8*)(ap + s * 64);
                fb0[i] = __builtin_bit_cast(bf16x8, bfr[(s * 2 + 0) * 64 + lane]); fb1[i] = __builtin_bit_cast(bf16x8, bfr[(s * 2 + 1) * 64 + lane]); }
            __builtin_amdgcn_sched_barrier(0);
#pragma unroll
            for (int i = 0; i < 4; ++i) { acc0 = __builtin_amdgcn_mfma_f32_16x16x32_bf16(fa[i], fb0[i], acc0, 0, 0, 0); acc1 = __builtin_amdgcn_mfma_f32_16x16x32_bf16(fa[i], fb1[i], acc1, 0, 0, 0); }
            __builtin_amdgcn_sched_barrier(0);
        }
        const int src = lane & 15;
        const float a0 = __shfl(acc0[0], src), a1 = __shfl(acc1[0], src), b0v = __shfl(acc0[1], src), b1v = __shfl(acc1[1], src);
        const int tok = mA + half; const bool valid = tok < t1;
        float v = (half == 0 ? ((lane & 16) ? a1 : a0) : ((lane & 16) ? b1v : b0v)) + rbias;
        if (!valid) v = -3.0e38f;
        float tv[4]; int te[4];
#pragma unroll
        for (int k = 0; k < 4; ++k) {
            const float mx = half_max(v);
            const unsigned long long bal = __ballot(v == mx);
            const unsigned bits = (unsigned)(bal >> (32 * half));
            const int sel = __ffs(bits) - 1;
            tv[k] = mx; te[k] = sel;
            if (e == sel) v = -3.0e38f;
        }
        const float e1 = __expf(tv[1] - tv[0]), e2 = __expf(tv[2] - tv[0]), e3 = __expf(tv[3] - tv[0]);
        const float inv = 1.0f / (1.0f + e1 + e2 + e3);
        if (valid && e < 4) {
            const int ee = e == 0 ? te[0] : e == 1 ? te[1] : e == 2 ? te[2] : te[3];
            const float ww = (e == 0 ? 1.0f : e == 1 ? e1 : e == 2 ? e2 : e3) * inv;
            const unsigned lp = atomicAdd((unsigned*)&lcnt[ee], 1u);
            TOPW[(size_t)tok * 4 + e] = ww;
            EPOS[(size_t)tok * 4 + e] = ((unsigned)ee << 24) | lp;
        }
    }
    __syncthreads();
    if (c.tid < 32) lbase[c.tid] = __hip_atomic_fetch_add(gcnt + 64 * c.tid, lcnt[c.tid], __ATOMIC_RELAXED, __HIP_MEMORY_SCOPE_AGENT);
    __syncthreads();
}
__global__ void __launch_bounds__(NTHREADS, 2) fwd_kernel(Params prm) {
    extern __shared__ __attribute__((aligned(16))) unsigned char lds_raw[];
    LAS unsigned char* const ldsl = (LAS unsigned char*)lds_raw;
    for (int u = threadIdx.x; u < (LDS_BYTES - LDSCTL_OFF) / 4; u += NTHREADS) ((LAS unsigned*)(ldsl + LDSCTL_OFF))[u] = 0u;
    __syncthreads();
    { const Ctx c = mk_ctx(prm, ldsl); (void)xcd_barrier_post(c.ctl() + CW_BAR, (volatile LAS unsigned*)(ldsl + LDSCTL_OFF)); }
#define CTX() const Ctx c = mk_ctx(prm, ldsl); unsigned char* const ws = c.ws; char* const ldsg = (char*)lds_raw; (void)ws; (void)ldsg
#ifndef REPMASK
#define REPMASK 0
#endif
#ifndef PROBEFLAG
#define PROBEFLAG 0
#endif
#define PRB(bit) (((((REPMASK) >> (bit)) & 1) && _rp < 2) ? PROBEFLAG : 0)
#define RPL(bit) _Pragma("unroll 1") for (int _rp = 0; _rp < ((((REPMASK) >> (bit)) & 1) ? 3 : 1); ++_rp)
#define GRID_BAR() do { XcdBarrier _b; _b.bar = launder((unsigned*)prm.ws) + CW_BAR; _b.x = xb_xcc_id(); _b.st = (volatile LAS unsigned*)(ldsl + LDSCTL_OFF); xcd_barrier(_b); } while (0)

    { CTX(); p0a_tables(c); } GRID_BAR();
    RPL(0) { CTX(); p0b_weights(c); } GRID_BAR();
    RPL(6) { CTX(); p_prenorm0(c); } GRID_BAR();

#pragma unroll 1
    for (int l = 0; l < 2; ++l) {
        const bool last = (l == 1);
        const int ntok = last ? TL : TT;
        if (l == 0) {
            RPL(1) { CTX(); pg8::DenseProb8 P{ws + WS_H8, ws + WS_WIN, 1024, TT / 256, EVEN_IN_PAD / 256, c.G, c.blk};
              LAS float* ropel = (LAS float*)(c.lds + LDSCTL_OFF + 8192);
              { const f32x4* src = (const f32x4*)(ws + WS_ROPE); ((LAS f32x4*)ropel)[c.tid] = src[c.tid]; }
              __syncthreads();
              pg8::EpiInproj E{c.r<bf16_t>(R_P), EVEN_IN_PAD, ropel};
              pg8::gemm_phase<pg8::DenseProb8, pg8::EpiInproj, true>(c.lds, P, E, c.tid); }
            GRID_BAR();
            { CTX(); p_even_post_inproj(c); } GRID_BAR();
            RPL(1) { CTX(); pg8::DenseProb P{c.r<bf16_t>(R_CQN), (const bf16_t*)(ws + WS_WQB), 512, TT / 256, 3, c.G, c.blk};
              pg8::EpiBf16W E{c.r<bf16_t>(R_QM), 768, 256, 128};
              pg8::gemm_phase(c.lds, P, E, c.tid); }
            RPL(1) { CTX(); pg8::DenseProb P{c.r<bf16_t>(R_CKVN), (const bf16_t*)(ws + WS_WKVB), 256, TT / 256, 4, c.G, c.blk};
              pg8::EpiBf16 E{c.r<bf16_t>(R_KVX), 1280, 320, 192};
              pg8::gemm_phase(c.lds, P, E, c.tid); }
            GRID_BAR();
            RPL(2) { CTX();
                const bf16_t* QM = c.r<bf16_t>(R_QM); const bf16_t* KVX = c.r<bf16_t>(R_KVX); bf16_t* AOM = c.r<bf16_t>(R_AOM);
#pragma unroll 1
                for (int u = c.vcu; u < 1152; u += c.G) {
                    int b, h, qrow0, nlat, NT;
                    if (u < 1024) { const int qt = u & 7; h = (u >> 3) & 3; b = u >> 5; qrow0 = b * SEQ + qt * 256; nlat = 32; NT = 36; }
                    else { const int v = u - 1024; h = v & 3; b = v >> 2; qrow0 = TL + b * CTXL; nlat = 0; NT = 4; }
                    att::attn_unit_pd<192>(QM + h * 192, 768, KVX + h * 320, 1280, KVX + h * 320 + 192, 1280, AOM + 512 + h * 128, 1024, qrow0, b * SEQ, nlat, TL + b * CTXL, NT, 0.07216878364870322f, ldsg, c.tid, (const float*)(ws + WS_ROPE));
                }
            }
            RPL(7) { CTX();
                const bf16_t* Pb = c.r<bf16_t>(R_P); bf16_t* AO = c.r<bf16_t>(R_AO);
#pragma unroll 1
                for (int u = c.vcu; u < 2304; u += c.G) {
                    int b, j, qrow0, nlat, NT;
                    if (u < 2048) { const int qt = u & 7; j = (u >> 3) & 7; b = u >> 6; qrow0 = b * SEQ + qt * 256; nlat = 32; NT = 36; }
                    else { const int v = u - 2048; j = v & 7; b = v >> 3; qrow0 = TL + b * CTXL; nlat = 0; NT = 4; }
                    const int hd = j >> 1, mp = j & 1;
                    att::attn_unit_pd<64>(Pb + hd * 128 + mp * 64, EVEN_IN_PAD, Pb + 512 + hd * 128 + mp * 64, EVEN_IN_PAD, Pb + 1024 + hd * 128, EVEN_IN_PAD, AO + j * 128, 1024,
                                          qrow0, b * SEQ, nlat, TL + b * CTXL, NT, 0.125f, ldsg, c.tid);
                }
            }
            GRID_BAR();
            RPL(8) { CTX(); p_diff_merge(c); } GRID_BAR();
            RPL(1) { CTX(); pg8::DenseProb P{c.r<bf16_t>(R_AOM), (const bf16_t*)(ws + WS_WOUT), 2048, TT / 256, 4, c.G, c.blk};
              pg8::EpiBf16W E{c.r<bf16_t>(R_Y), 1024, 256, 128};
              pg8::gemm_phase(c.lds, P, E, c.tid); }
            GRID_BAR();
        } else {
            RPL(1) { CTX(); pg8::DenseProb8 P{ws + WS_H8, ws + WS_WQKV, 1024, TT / 256, 12, c.G, c.blk};
              pg8::EpiBf16W E{c.r<bf16_t>(R_QKV), 3072, 256, 128};
              pg8::gemm_phase<pg8::DenseProb8, pg8::EpiBf16W, true>(c.lds, P, E, c.tid); }
            GRID_BAR();
            RPL(3) { CTX(); const bf16_t* QKV = c.r<bf16_t>(R_QKV); bf16_t* NAO = c.r<bf16_t>(R_NAO); const float* rpb = c.in(I_NARPB);
#pragma unroll 1
              for (int u = c.vcu; u < NB * 16 * 8; u += c.G) na::na_unit(QKV, rpb, NAO, u, ldsg, c.tid, (u == c.vcu) || (c.G & 127) != 0);
            }
            GRID_BAR();
            RPL(1) { CTX(); pg8::DenseProb P{c.r<bf16_t>(R_NAO), (const bf16_t*)(ws + WS_WNAO), 2048, TL / 256, 4, c.G, c.blk};
              pg8::EpiBf16W E{c.r<bf16_t>(R_Y), 1024, 256, 128};
              pg8::gemm_phase(c.lds, P, E, c.tid); }
            GRID_BAR();
        }
        { CTX(); p_postmix_route(c, l, ntok); } GRID_BAR();
        if (STOP_AFTER == 1 + 2 * l) return;
        { CTX(); p_route_b(c, l, ntok); } GRID_BAR();
        RPL(4) { CTX(); const int nT = __builtin_amdgcn_readfirstlane((int)c.misc()[MW_NT + l]); const int* tile_e = (const int*)c.misc() + MW_TILEE + l * 2048;
          pg8::Moe1Prob P{ws + WS_H8, ws + WS_W1 + (size_t)l * 32 * 2048 * 1024, c.r<unsigned>(R_ROWTOK), tile_e, 1024, nT, c.G, c.blk};
          pg8::EpiSwiglu E{c.r<unsigned char>(R_ACT), c.in(I_B1) + (size_t)l * 32 * 2048};
          pg8::gemm_phase<pg8::Moe1Prob, pg8::EpiSwiglu, true>(c.lds, P, E, c.tid, PRB(4)); }
        GRID_BAR();
        RPL(5) { CTX(); const int nT = __builtin_amdgcn_readfirstlane((int)c.misc()[MW_NT + l]); const int* tile_e = (const int*)c.misc() + MW_TILEE + l * 2048;
          pg8::Moe2Prob P{c.r<unsigned char>(R_ACT), ws + WS_W2 + (size_t)l * 32 * 1024 * 1024, tile_e, 1024, nT, c.G, c.blk};
          pg8::EpiF8 E{c.r<unsigned char>(R_EO), 1024, c.in(I_B2) + (size_t)l * 32 * 1024, 1024};
          pg8::gemm_phase<pg8::Moe2Prob, pg8::EpiF8, true>(c.lds, P, E, c.tid, PRB(5)); }
        GRID_BAR();
        { CTX(); p_postffn(c, l, ntok, last); }
        if (STOP_AFTER == 2 + 2 * l) return;
        if (!last) GRID_BAR();
    }
#undef GRID_BAR
#undef CTX
}

extern "C" void kernel_launch(void* const* d_in, const int* in_sizes, int n_in, void* d_out, int out_size, void* d_ws, size_t ws_size, hipStream_t stream) {
    static int grid = 0;
    if (grid == 0) {
        if (n_in != 27 || out_size != TL * DM || ws_size < WS_END) { fprintf(stderr, "kernel_launch: unexpected shapes: n_in %d out %d ws %zu (need %zu)\n", n_in, out_size, ws_size, (size_t)WS_END); grid = -1; return; }
        int dev = 0, cus = 0, per_cu = 0;
        if (hipGetDevice(&dev) != hipSuccess || hipDeviceGetAttribute(&cus, hipDeviceAttributeMultiprocessorCount, dev) != hipSuccess) { grid = -1; return; }
        if (hipFuncSetAttribute((const void*)fwd_kernel, hipFuncAttributeMaxDynamicSharedMemorySize, LDS_BYTES) != hipSuccess) { fprintf(stderr, "kernel_launch: hipFuncSetAttribute failed\n"); grid = -1; return; }
        if (hipOccupancyMaxActiveBlocksPerMultiprocessor(&per_cu, (const void*)fwd_kernel, NTHREADS, LDS_BYTES) != hipSuccess || per_cu < 1) { fprintf(stderr, "kernel_launch: occupancy query says %d\n", per_cu); }
        (void)hipGetLastError();
        grid = cus;
    }
    if (grid < 0) return;
    if (hipMemsetAsync((char*)d_ws + WS_CTL, 0, CTL_ZERO_BYTES, stream) != hipSuccess) return;
    Params p{};
    for (int i = 0; i < 27; ++i) p.in[i] = (const float*)d_in[i];
    p.out = (float*)d_out; p.ws = (unsigned char*)d_ws;
    hipLaunchKernelGGL(fwd_kernel, dim3(grid), dim3(NTHREADS), LDS_BYTES, stream, p);
    const hipError_t le = hipPeekAtLastError();
    if (le != hipSuccess) fprintf(stderr, "kernel_launch: launch failed: %s\n", hipGetErrorName(le));
}
```

```cpp
#include <hip/hip_runtime.h>
#include <cstdio>
#include <cstdint>

#ifndef STOP_AFTER
#define STOP_AFTER 99
#endif

typedef unsigned short bf16_t;
typedef short bf16x8 __attribute__((ext_vector_type(8)));
typedef short s16x4 __attribute__((ext_vector_type(4)));
typedef float f32x4 __attribute__((ext_vector_type(4)));
typedef float f32x2 __attribute__((ext_vector_type(2)));
typedef float f32x16 __attribute__((ext_vector_type(16)));
typedef unsigned u32x4 __attribute__((ext_vector_type(4)));
typedef unsigned u32x2 __attribute__((ext_vector_type(2)));
#define LAS __attribute__((address_space(3)))
#define DI __device__ __forceinline__

constexpr int DM = 1024, NB = 32, SEQ = 2048, CTXL = 256, GRIDW = 64;
constexpr int TL = NB * SEQ, TC = NB * CTXL, TT = TL + TC;
constexpr int NE = 32, DFF = 1024;
constexpr int NWAVES = 8, NTHREADS = 512;
constexpr float EPS = 1e-6f;
constexpr int EVEN_IN_W = 1984, EVEN_IN_PAD = 2048;
constexpr int MAXTILES = 1184;

constexpr size_t MiB = 1u << 20;
constexpr size_t WS_CTL = 0, CTL_ZERO_BYTES = 1 * MiB;
constexpr size_t WS_MOD = 1 * MiB;
constexpr size_t WS_SCT = 3 * MiB;
constexpr size_t WS_ROPE = 3 * MiB + 256 * 1024;
constexpr size_t WS_MISC = 3 * MiB + 512 * 1024;
constexpr size_t WS_WIN = 4 * MiB, WS_WQB = 8 * MiB, WS_WKVB = 9 * MiB, WS_WOUT = 10 * MiB, WS_WQKV = 12 * MiB, WS_WNAO = 18 * MiB, WS_WR = 20 * MiB;
constexpr size_t WS_W1 = 22 * MiB, WS_W2 = 278 * MiB, WS_XC = 406 * MiB, WS_H = 438 * MiB, WS_R = 582 * MiB;
constexpr size_t R_P = 0, R_CQN = 288 * MiB, R_CKVN = 324 * MiB, R_QM = 342 * MiB, R_KVX = 450 * MiB  , R_AO = 630 * MiB, R_AOM = 774 * MiB, R_Y = 990 * MiB;
constexpr size_t R_QKV = 0, R_VT = 432 * MiB, R_NAO = 576 * MiB;
constexpr size_t R_LG = 0, R_TOPW = 9 * MiB, R_EPOS = 11 * MiB, R_SLOT = 13 * MiB, R_ROWTOK = 15 * MiB, R_ACT = 17 * MiB, R_EO = 609 * MiB;
constexpr size_t WS_H8 = WS_R + 1201 * MiB;
constexpr size_t WS_END = WS_H8 + 72 * MiB;
constexpr int CW_BAR = 4096;
constexpr int CW_CNT = 16384;
constexpr int MW_LAM = 0, MW_NT = 16  , MW_TSTART = 64  , MW_TILEE = 256  ;

constexpr int RING_BYTES = 131072, LDSCTL_OFF = RING_BYTES, MISC_OFF = LDSCTL_OFF + 320, LDS_BYTES = 147456;

DI unsigned f2bf(float f) { unsigned u = __builtin_bit_cast(unsigned, f); return (u + 0x7fffu + ((u >> 16) & 1u)) >> 16; }
DI unsigned pk2(float lo, float hi) { return f2bf(lo) | (f2bf(hi) << 16); }
DI float bflo(unsigned w) { return __builtin_bit_cast(float, w << 16); }
DI float bfhi(unsigned w) { return __builtin_bit_cast(float, w & 0xffff0000u); }
DI unsigned cvt_pk_bf16(float lo, float hi) { unsigned r; asm volatile("v_cvt_pk_bf16_f32 %0, %1, %2" : "=v"(r) : "v"(lo), "v"(hi)); return r; }
DI unsigned pk4_fp8(float a, float b, float c, float d) { unsigned w = 0; w = __builtin_amdgcn_cvt_pk_fp8_f32(a, b, w, false); w = __builtin_amdgcn_cvt_pk_fp8_f32(c, d, w, true); return w; }
template <int CTRL> DI float dppf(float v) { return __builtin_bit_cast(float, __builtin_amdgcn_update_dpp(0, __builtin_bit_cast(int, v), CTRL, 0xf, 0xf, true)); }
DI float row16_sum(float v) { v += dppf<0xB1>(v); v += dppf<0x4E>(v); v += dppf<0x141>(v); v += dppf<0x140>(v); return v; }
DI float half_sum(float v) { v = row16_sum(v); auto r = __builtin_amdgcn_permlane16_swap(__builtin_bit_cast(unsigned, v), __builtin_bit_cast(unsigned, v), false, false); return __uint_as_float(r[0]) + __uint_as_float(r[1]); }
DI float wave_sum(float v) { v = half_sum(v); auto r = __builtin_amdgcn_permlane32_swap(__builtin_bit_cast(unsigned, v), __builtin_bit_cast(unsigned, v), false, false); return __uint_as_float(r[0]) + __uint_as_float(r[1]); }
DI float half_max(float v) {
    v = fmaxf(v, dppf<0xB1>(v)); v = fmaxf(v, dppf<0x4E>(v)); v = fmaxf(v, dppf<0x141>(v)); v = fmaxf(v, dppf<0x140>(v));
    auto r = __builtin_amdgcn_permlane16_swap(__builtin_bit_cast(unsigned, v), __builtin_bit_cast(unsigned, v), false, false); return fmaxf(__uint_as_float(r[0]), __uint_as_float(r[1]));
}
#define LDS_WAIT() asm volatile("s_waitcnt lgkmcnt(0)" ::: "memory")
#define VM_WAIT() asm volatile("s_waitcnt vmcnt(0)" ::: "memory")

#define XB_TMO      128
#define XB_XCNT(j)  (256  + 64 * (j))
#define XB_XSUB(j)  (1280 + 64 * (j))
#define XB_XGEN(j)  (2304 + 64 * (j))
#define XB_TOP      3328
#define XB_TOPGEN   3392
#define XCD_BAR_WORDS 3456
#define XB_SPIN_CAP (1u << 20)

__device__ __forceinline__ unsigned xb_ld(unsigned* p)              { return __hip_atomic_load(p, __ATOMIC_RELAXED, __HIP_MEMORY_SCOPE_AGENT); }
__device__ __forceinline__ unsigned xb_add(unsigned* p, unsigned v) { return __hip_atomic_fetch_add(p, v, __ATOMIC_RELAXED, __HIP_MEMORY_SCOPE_AGENT); }
__device__ __forceinline__ unsigned xb_xcc_id() { return (unsigned)__builtin_amdgcn_s_getreg((3 << 11) | 20) & 0xFu; }
#define XB_SPIN(cond, bar) do { unsigned _sp = 0; while (cond) { __builtin_amdgcn_s_sleep(1); \
    if ((++_sp & 255u) == 0u) { if (xb_ld(&(bar)[XB_TMO])) break; if (_sp > XB_SPIN_CAP) { atomicAdd(&(bar)[XB_TMO], 1u); break; } } } } while (0)

struct XcdBarrier { unsigned* bar; unsigned x; volatile LAS unsigned* st; };

__device__ __forceinline__ XcdBarrier xcd_barrier_post(unsigned* bar, volatile LAS unsigned* st) {
    XcdBarrier b; b.bar = bar; b.x = xb_xcc_id(); b.st = st;
    if (threadIdx.x == 0) (void)xb_add(&bar[XB_XCNT(b.x)], 1u);
    return b;
}
__device__ __forceinline__ void xcd_barrier_complete(unsigned* bar, unsigned x, unsigned& nloc, unsigned& nx) {
    const unsigned G = gridDim.x * gridDim.y * gridDim.z;
    unsigned sum, cnt, mine, sp = 0u;
    for (;;) {
        sum = 0u; cnt = 0u; mine = 0u;
#pragma unroll 1
        for (unsigned j = 0; j < 16; ++j) { const unsigned c = xb_ld(&bar[XB_XCNT(j)]); sum += c; cnt += (c > 0u) ? 1u : 0u; mine = (j == x) ? c : mine; }
        if (sum == G) break;
        __builtin_amdgcn_s_sleep(1);
        if ((++sp & 255u) == 0u) { if (xb_ld(&bar[XB_TMO])) break; if (sp > XB_SPIN_CAP) { atomicAdd(&bar[XB_TMO], 1u); break; } }
    }
    nloc = mine > 0u ? mine : 1u; nx = cnt > 0u ? cnt : 1u;
}
__device__ __forceinline__ void xcd_barrier(const XcdBarrier& b) {
    asm volatile("s_waitcnt vmcnt(0)" ::: "memory");
    __syncthreads();
    if (threadIdx.x == 0) {
        unsigned* bar = b.bar;
        __builtin_amdgcn_s_waitcnt(0);
        unsigned nloc = b.st[0], nx = b.st[1];
        if (nloc == 0u) { xcd_barrier_complete(bar, b.x, nloc, nx); b.st[0] = nloc; b.st[1] = nx; }
        const unsigned old = xb_add(&bar[XB_XSUB(b.x)], 1u);
        const unsigned gen = old / nloc;
        if (old + 1u == (gen + 1u) * nloc) {
            __builtin_amdgcn_fence(__ATOMIC_RELEASE, "agent");
            asm volatile("s_waitcnt vmcnt(0)" ::: "memory");
            const unsigned og = xb_add(&bar[XB_TOP], 1u);
            const unsigned tg = og / nx;
            if (og + 1u == (tg + 1u) * nx) xb_add(&bar[XB_TOPGEN], 1u);
            else XB_SPIN(xb_ld(&bar[XB_TOPGEN]) == tg, bar);
            __builtin_amdgcn_fence(__ATOMIC_ACQUIRE, "agent");
            xb_add(&bar[XB_XGEN(b.x)], 1u);
            asm volatile("s_waitcnt vmcnt(0)" ::: "memory");
        } else {
            XB_SPIN(xb_ld(&bar[XB_XGEN(b.x)]) == gen, bar);
            __builtin_amdgcn_fence(__ATOMIC_ACQUIRE, "agent");
            asm volatile("s_waitcnt vmcnt(0)" ::: "memory");
        }
    }
    __syncthreads();
}
namespace pg8 {
constexpr int BM = 256, BK = 64, HALF = 128, HTB = HALF * BK * 2, STAGE_BYTES = 8 * HTB, NXCD = 8, WGM = 8;
DI int lds_byte(int r, int c) { const int st = (r >> 4) * 2 + (c >> 5), rr = r & 15, cc = c & 31, ob = rr * 64 + cc * 2; return st * 1024 + (ob ^ (((ob >> 9) & 1) << 5)); }
DI void stage_rc(int b, int& R, int& C) { const int st = b / 1024, sb = b % 1024, swz = sb ^ (((sb >> 9) & 1) << 5); R = (st >> 1) * 16 + swz / 64; C = (st & 1) * 32 + (swz % 64) / 2; }
DI int perm32(int rho) { const int n = rho >> 4, i = rho & 15; return 8 * (i >> 2) + 4 * n + (i & 3); }

struct Unit { int pm, pn, e; };
DI bool static_unit(int i, int G, int c, int nM, int nN, Unit& u) {
    const int nwg = nM * nN; const long L = (long)i * G + c; if (L >= nwg) return false;
    int wgid = (int)L; { const int q = nwg / NXCD, r = nwg % NXCD, xcd = wgid % NXCD, off = wgid / NXCD; wgid = (xcd < r ? xcd * (q + 1) : r * (q + 1) + (xcd - r) * q) + off; }
    const int nig = WGM * nN, gid = wgid / nig, fm = gid * WGM, gsz = (nM - fm) < WGM ? (nM - fm) : WGM;
    u.pm = fm + ((wgid % nig) % gsz); u.pn = (wgid % nig) / gsz; u.e = 0; return true;
}

typedef int v8i __attribute__((ext_vector_type(8)));
typedef int v4i __attribute__((ext_vector_type(4)));
template <class Prob, class Epi, bool F8 = false>
DI void gemm_phase(LAS unsigned char* lds, const Prob& P, const Epi& E, int tid, int probe = 0) {
    const int wid = __builtin_amdgcn_readfirstlane(tid >> 6), lane = tid & 63, wr = wid >> 2, wc = wid & 3, fr = lane & 15, fq = lane >> 4;
    int Kv = P.KB; asm volatile("" : "+s"(Kv));
    const int KB = Kv, nt = (probe & 2) ? KB / 256 : KB / 128;
    unsigned voffB0[2], voffB1[2];
#pragma unroll
    for (int i = 0; i < 2; ++i) { int R, C; stage_rc(tid * 16 + i * 8192, R, C);
        if constexpr (Epi::WIDE) { const int wcc = R >> 5, rho = R & 31, nn = rho >> 4, ii = rho & 15, colb = wcc * 64 + (ii >> 2) * 16 + nn * 4 + (ii & 3);
            voffB0[i] = (unsigned)(colb * KB + C * 2); voffB1[i] = (unsigned)((colb + 8) * KB + C * 2); }
        else { const int Rb = Epi::PERM ? ((R & ~31) + perm32(R & 31)) : R; voffB0[i] = (unsigned)(Rb * KB + C * 2); voffB1[i] = voffB0[i]; } }
    const size_t kstep = (size_t)(BK * 2);
    const unsigned ldsw = (unsigned)wid * 1024u;
    const int aoff = lds_byte(wr * 64 + fr, fq * 8), boff = lds_byte(wc * 32 + fr, fq * 8);
#define PG8_SA(b, h) (((b) * 2 + (h)) * HTB)
#define PG8_SB(b, h) ((4 + (b) * 2 + (h)) * HTB)
#define PG8_STAGE_B(bufoff, gptr, voffB) do { const char* _g = (const char*)(gptr); asm volatile("" : "+s"(_g)); _Pragma("unroll") for (int _i = 0; _i < 2; ++_i) \
        { unsigned _o = voffB[_i]; asm volatile("" : "+v"(_o)); __builtin_amdgcn_global_load_lds((const unsigned*)(_g + _o), (LAS unsigned*)(lds + (bufoff) + ldsw + _i * 8192), 16, 0, 0); } } while (0)
#define PG8_STAGE_A(bufoff, gptr, offs) do { const char* _g = (const char*)(gptr); asm volatile("" : "+s"(_g)); _Pragma("unroll") for (int _i = 0; _i < 2; ++_i) \
        { unsigned _o = (offs)[_i]; asm volatile("" : "+v"(_o)); __builtin_amdgcn_global_load_lds((const unsigned*)(_g + _o), (LAS unsigned*)(lds + (bufoff) + ldsw + _i * 8192), 16, 0, 0); } } while (0)
#define PG8_LDA(dst, b, h) do { _Pragma("unroll") for (int m = 0; m < 4; ++m) _Pragma("unroll") for (int k = 0; k < 2; ++k) dst[m][k] = *(const LAS bf16x8*)(lds + PG8_SA(b, h) + aoff + m * 2048 + k * 1024); } while (0)
#define PG8_LDB(dst, b, h) do { _Pragma("unroll") for (int n = 0; n < 2; ++n) _Pragma("unroll") for (int k = 0; k < 2; ++k) dst[n][k] = *(const LAS bf16x8*)(lds + PG8_SB(b, h) + boff + n * 2048 + k * 1024); } while (0)
#define PG8_CAT(x) __builtin_bit_cast(v8i, __builtin_shufflevector(__builtin_bit_cast(v4i, (x)[0]), __builtin_bit_cast(v4i, (x)[1]), 0, 1, 2, 3, 4, 5, 6, 7))
#define PG8_MMA(ai, bj, At, Bt) do { __builtin_amdgcn_s_setprio(1); _Pragma("unroll") for (int m = 0; m < 4; ++m) _Pragma("unroll") for (int n = 0; n < 2; ++n) { \
        if constexpr (F8) acc[ai][bj][m][n] = __builtin_amdgcn_mfma_scale_f32_16x16x128_f8f6f4(PG8_CAT(Bt[n]), PG8_CAT(At[m]), acc[ai][bj][m][n], 0, 0, 0, 0x7a7a7a7a, 0, 0x7f7f7f7f); \
        else { _Pragma("unroll") for (int k = 0; k < 2; ++k) acc[ai][bj][m][n] = __builtin_amdgcn_mfma_f32_16x16x32_bf16(Bt[n][k], At[m][k], acc[ai][bj][m][n], 0, 0, 0); } } \
        __builtin_amdgcn_s_setprio(0); } while (0)
#define PG8_WAIT_V(n) asm volatile("s_waitcnt vmcnt(" #n ")" ::: "memory")
#define PG8_WAIT_L(n) asm volatile("s_waitcnt lgkmcnt(" #n ")" ::: "memory")
#define PG8_BAR __builtin_amdgcn_s_barrier()
#define PG8_SCHED __builtin_amdgcn_sched_barrier(0)
    LAS unsigned char* const hdr = lds + STAGE_BYTES + 1024;
#define PG8_HROW(u_) ((LAS unsigned*)(hdr + ((u_) % 3) * 2048))
#define PG8_HBIAS(u_) ((LAS float*)(hdr + ((u_) % 3) * 2048 + 1024))
#define PG8_LOAD_HDR(un, u_) do { \
        if constexpr (Prob::GATHER) { if (wid < 4) __builtin_amdgcn_global_load_lds((const unsigned*)(P.rowtok + (un).pm * BM + wid * 64 + lane), (LAS unsigned*)(PG8_HROW(u_) + wid * 64), 4, 0, 0); } \
        if constexpr (Epi::BIAS) { if (wid >= 4) __builtin_amdgcn_global_load_lds((const unsigned*)(E.bias_src(un, (wid - 4) * 64) + lane), (LAS unsigned*)(PG8_HBIAS(u_) + (wid - 4) * 64), 4, 0, 0); } } while (0)
    Unit cur, nxt; int ui = 0;
    if (!P.next(0, cur)) return;
    if constexpr (Prob::GATHER || Epi::BIAS) { PG8_LOAD_HDR(cur, 0); asm volatile("s_waitcnt vmcnt(0)" ::: "memory"); __builtin_amdgcn_s_barrier(); asm volatile("" ::: "memory"); }
    f32x4 acc[2][2][4][2];
#pragma unroll
    for (int a = 0; a < 2; ++a)
#pragma unroll
        for (int b = 0; b < 2; ++b)
#pragma unroll
            for (int m = 0; m < 4; ++m)
#pragma unroll
                for (int n = 0; n < 2; ++n) acc[a][b][m][n] = (f32x4){0.f, 0.f, 0.f, 0.f};
    bf16x8 At[4][2], B0[2][2], B1[2][2];
    unsigned oa0[2], oa1[2];
#pragma unroll
    for (int i = 0; i < 2; ++i) { int R, C; stage_rc(tid * 16 + i * 8192, R, C); oa0[i] = P.a_lane(cur, 0, R, C, PG8_HROW(0)); oa1[i] = P.a_lane(cur, 1, R, C, PG8_HROW(0)); }
    const char* cA0 = P.a_base(cur, 0); const char* cA1 = P.a_base(cur, 1);
    const char* cB0 = P.b_base(cur, 0); const char* cB1 = P.b_base(cur, Epi::WIDE ? 0 : 1);
    PG8_STAGE_B(PG8_SB(0, 0), cB0, voffB0); PG8_STAGE_B(PG8_SB(0, 1), cB1, voffB1); PG8_STAGE_A(PG8_SA(0, 0), cA0, oa0); PG8_STAGE_A(PG8_SA(0, 1), cA1, oa1);
    if (wr == 1) PG8_BAR;
    PG8_WAIT_V(2); PG8_BAR;
    PG8_STAGE_B(PG8_SB(1, 0), cB0 + kstep, voffB0); PG8_STAGE_A(PG8_SA(1, 0), cA0 + kstep, oa0); PG8_STAGE_B(PG8_SB(1, 1), cB1 + kstep, voffB1);
    PG8_WAIT_V(6); PG8_BAR;
    for (;;) {
        const bool has_next = P.next(ui + 1, nxt);
        if constexpr (Prob::GATHER || Epi::BIAS) { if (has_next) PG8_LOAD_HDR(nxt, ui + 1); }
        for (int t = 0; t < nt; t += 2) {
            const bool last = (t == nt - 2);
            PG8_LDB(B0, 0, 0); PG8_LDB(B1, 0, 1); PG8_SCHED; PG8_LDA(At, 0, 0); PG8_STAGE_A(PG8_SA(1, 1), cA1 + (size_t)(t + 1) * kstep, oa1);
            PG8_WAIT_V(8); PG8_WAIT_L(0); PG8_BAR; PG8_MMA(0, 0, At, B0); PG8_MMA(0, 1, At, B1); PG8_BAR; PG8_SCHED;
            size_t k2 = (size_t)(t + 2) * kstep;
            if (last) { k2 = 0; if (has_next) { cB0 = P.b_base(nxt, 0); cB1 = P.b_base(nxt, Epi::WIDE ? 0 : 1); cA0 = P.a_base(nxt, 0); cA1 = P.a_base(nxt, 1);
#pragma unroll
                for (int i = 0; i < 2; ++i) { int R, C; stage_rc(tid * 16 + i * 8192, R, C); oa0[i] = P.a_lane(nxt, 0, R, C, PG8_HROW(ui + 1)); oa1[i] = P.a_lane(nxt, 1, R, C, PG8_HROW(ui + 1)); } } }
            const size_t k3 = k2 + kstep;
            PG8_LDA(At, 0, 1); PG8_STAGE_B(PG8_SB(0, 0), cB0 + k2, voffB0); PG8_STAGE_B(PG8_SB(0, 1), cB1 + k2, voffB1); PG8_STAGE_A(PG8_SA(0, 0), cA0 + k2, oa0);
            PG8_WAIT_V(8); PG8_WAIT_L(0); PG8_BAR; PG8_MMA(1, 0, At, B0); PG8_MMA(1, 1, At, B1); PG8_BAR; PG8_SCHED;
            PG8_LDB(B0, 1, 0); PG8_LDB(B1, 1, 1); PG8_SCHED; PG8_LDA(At, 1, 0); PG8_STAGE_A(PG8_SA(0, 1), cA1 + k2, oa1);
            PG8_WAIT_V(8); PG8_WAIT_L(0); PG8_BAR; PG8_MMA(0, 0, At, B0); PG8_MMA(0, 1, At, B1); PG8_BAR; PG8_SCHED;
            PG8_LDA(At, 1, 1); PG8_STAGE_B(PG8_SB(1, 0), cB0 + k3, voffB0); PG8_STAGE_B(PG8_SB(1, 1), cB1 + k3, voffB1); PG8_STAGE_A(PG8_SA(1, 0), cA0 + k3, oa0);
            PG8_WAIT_V(8); PG8_WAIT_L(0); PG8_BAR; PG8_MMA(1, 0, At, B0); PG8_MMA(1, 1, At, B1); PG8_BAR; PG8_SCHED;
        }
        if (wr == 0) PG8_BAR;
        if (!(probe & 1)) E(acc, cur, wr, wc, fr, fq, PG8_HBIAS(ui));
        if (!has_next) break;
#pragma unroll
        for (int a = 0; a < 2; ++a)
#pragma unroll
            for (int b = 0; b < 2; ++b)
#pragma unroll
                for (int m = 0; m < 4; ++m)
#pragma unroll
                    for (int n = 0; n < 2; ++n) acc[a][b][m][n] = (f32x4){0.f, 0.f, 0.f, 0.f};
        cur = nxt; ++ui;
        if (wr == 1) PG8_BAR;
    }
    PG8_WAIT_V(0);
    PG8_BAR;
#undef PG8_HROW
#undef PG8_HBIAS
#undef PG8_LOAD_HDR
#undef PG8_SA
#undef PG8_SB
#undef PG8_STAGE_A
#undef PG8_STAGE_B
#undef PG8_LDA
#undef PG8_LDB
#undef PG8_MMA
#undef PG8_CAT
#undef PG8_WAIT_V
#undef PG8_WAIT_L
#undef PG8_BAR
#undef PG8_SCHED
}

struct DenseProb {
    static constexpr bool GATHER = false;
    const bf16_t* A; const bf16_t* Bt; int KB  , nM, nN, G, c;
    DI bool next(int i, Unit& u) const { return static_unit(i, G, c, nM, nN, u); }
    DI unsigned a_lane(const Unit&, int, int R, int C, const LAS unsigned*) const { return (unsigned)(R * KB + C * 2); }
    DI const char* a_base(const Unit& u, int h) const { return (const char*)A + (size_t)(u.pm * BM + h * HALF) * KB; }
    DI const char* b_base(const Unit& u, int h) const { return (const char*)Bt + (size_t)(u.pn * BM + h * HALF) * KB; }
};
struct DenseProb8 {
    static constexpr bool GATHER = false;
    const unsigned char* A; const unsigned char* Bt; int KB, nM, nN, G, c;
    DI bool next(int i, Unit& u) const { return static_unit(i, G, c, nM, nN, u); }
    DI unsigned a_lane(const Unit&, int, int R, int C, const LAS unsigned*) const { return (unsigned)(R * KB + C * 2); }
    DI const char* a_base(const Unit& u, int h) const { return (const char*)A + (size_t)(u.pm * BM + h * HALF) * KB; }
    DI const char* b_base(const Unit& u, int h) const { return (const char*)Bt + (size_t)(u.pn * BM + h * HALF) * KB; }
};
struct Moe1Prob {
    static constexpr bool GATHER = true;
    const unsigned char* A; const unsigned char* W1t; const unsigned* rowtok; const int* tile_e; int KB, nM, G, c;
    DI bool next(int i, Unit& u) const { if (!static_unit(i, G, c, nM, 8, u)) return false; u.e = __builtin_amdgcn_readfirstlane(tile_e[u.pm]); return true; }
    DI unsigned a_lane(const Unit&, int h, int R, int C, const LAS unsigned* hrow) const { return hrow[h * HALF + R] * (unsigned)KB + (unsigned)(C * 2); }
    DI const char* a_base(const Unit&, int) const { return (const char*)A; }
    DI const char* b_base(const Unit& u, int h) const { return (const char*)W1t + ((size_t)u.e * 2048 + (size_t)h * 1024 + (size_t)u.pn * 128) * KB; }
};
struct Moe2Prob {
    static constexpr bool GATHER = false;
    const unsigned char* A; const unsigned char* W2t; const int* tile_e; int KB, nM, G, c;
    DI bool next(int i, Unit& u) const { if (!static_unit(i, G, c, nM, 4, u)) return false; u.e = __builtin_amdgcn_readfirstlane(tile_e[u.pm]); return true; }
    DI unsigned a_lane(const Unit&, int, int R, int C, const LAS unsigned*) const { return (unsigned)(R * KB + C * 2); }
    DI const char* a_base(const Unit& u, int h) const { return (const char*)A + (size_t)(u.pm * BM + h * HALF) * KB; }
    DI const char* b_base(const Unit& u, int h) const { return (const char*)W2t + ((size_t)u.e * 1024 + (size_t)u.pn * BM + (size_t)h * HALF) * KB; }
};

template <bool W> struct EpiBf16T {
    static constexpr bool PERM = true, BIAS = false, WIDE = W;
    bf16_t* O; int ldc; int tcol, hcol;
    DI const float* bias_src(const Unit&, int) const { return nullptr; }
    DI void operator()(const f32x4 (&acc)[2][2][4][2], const Unit& u, int wr, int wc, int fr, int fq, const LAS float*) const {
        const int row0 = u.pm * BM + wr * 64 + fr, ocol0 = W ? u.pn * BM + wc * 64 + 16 * fq : u.pn * tcol + wc * 32 + 8 * fq;
#pragma unroll
        for (int ai = 0; ai < 2; ++ai)
#pragma unroll
            for (int m = 0; m < 4; ++m) { bf16_t* rowp = O + (size_t)(row0 + ai * HALF + m * 16) * ldc + ocol0;
#pragma unroll
                for (int bj = 0; bj < 2; ++bj) { const f32x4 v0 = acc[ai][bj][m][0], v1 = acc[ai][bj][m][1];
                    u32x4 w; w.x = cvt_pk_bf16(v0[0], v0[1]); w.y = cvt_pk_bf16(v0[2], v0[3]); w.z = cvt_pk_bf16(v1[0], v1[1]); w.w = cvt_pk_bf16(v1[2], v1[3]);
                    *(u32x4*)(rowp + bj * (W ? 8 : hcol)) = w; } }
    }
};
typedef EpiBf16T<true> EpiBf16W; typedef EpiBf16T<false> EpiBf16;
struct EpiInproj {
    static constexpr bool PERM = true, BIAS = false, WIDE = true;
    bf16_t* O; int ldc; const LAS float* ropel;
    DI const float* bias_src(const Unit&, int) const { return nullptr; }
    DI void operator()(const f32x4 (&acc)[2][2][4][2], const Unit& u, int wr, int wc, int fr, int fq, const LAS float*) const {
        const int row0 = u.pm * BM + wr * 64 + fr, ocol0 = u.pn * BM + wc * 64 + 16 * fq;
        const bool rot = (u.pn < 4) && (u.pm < TL / BM);
        const float sgn = (fq & 1) ? 1.0f : -1.0f;
#pragma unroll
        for (int ai = 0; ai < 2; ++ai)
#pragma unroll
            for (int m = 0; m < 4; ++m) { const int row = row0 + ai * HALF + m * 16; bf16_t* rowp = O + (size_t)row * ldc + ocol0;
                float v[16];
#pragma unroll
                for (int bj = 0; bj < 2; ++bj)
#pragma unroll
                    for (int n = 0; n < 2; ++n)
#pragma unroll
                        for (int j = 0; j < 4; ++j) v[8 * bj + 4 * n + j] = acc[ai][bj][m][n][j];
                if (rot) { const int sq = row & (SEQ - 1), pos = (fq < 2) ? (sq >> 6) : (sq & (GRIDW - 1));
                    const LAS f32x4* cs = (const LAS f32x4*)(ropel + pos * 32);
#pragma unroll
                    for (int q = 0; q < 8; ++q) { const f32x4 c2 = cs[q];
                        const float p0 = __shfl_xor(v[2 * q], 16), p1 = __shfl_xor(v[2 * q + 1], 16);
                        v[2 * q] = v[2 * q] * c2[0] + sgn * p0 * c2[1]; v[2 * q + 1] = v[2 * q + 1] * c2[2] + sgn * p1 * c2[3]; } }
                u32x4 w0, w1;
                w0.x = cvt_pk_bf16(v[0], v[1]); w0.y = cvt_pk_bf16(v[2], v[3]); w0.z = cvt_pk_bf16(v[4], v[5]); w0.w = cvt_pk_bf16(v[6], v[7]);
                w1.x = cvt_pk_bf16(v[8], v[9]); w1.y = cvt_pk_bf16(v[10], v[11]); w1.z = cvt_pk_bf16(v[12], v[13]); w1.w = cvt_pk_bf16(v[14], v[15]);
                *(u32x4*)rowp = w0; *(u32x4*)(rowp + 8) = w1; }
    }
};
struct EpiF8 {
    static constexpr bool PERM = true, BIAS = true, WIDE = true;
    unsigned char* O; int ldc; const float* bias; int bias_estride;
    DI const float* bias_src(const Unit& u, int idx0) const { return bias + (size_t)u.e * bias_estride + u.pn * BM + idx0; }
    DI void operator()(const f32x4 (&acc)[2][2][4][2], const Unit& u, int wr, int wc, int fr, int fq, const LAS float* hb) const {
        const int row0 = u.pm * BM + wr * 64 + fr, x0 = wc * 64 + 16 * fq, col0 = u.pn * BM + x0;
        f32x4 bv[2][2];
#pragma unroll
        for (int bj = 0; bj < 2; ++bj)
#pragma unroll
            for (int n = 0; n < 2; ++n) bv[bj][n] = *(const LAS f32x4*)(hb + x0 + 8 * bj + 4 * n);
#pragma unroll
        for (int ai = 0; ai < 2; ++ai)
#pragma unroll
            for (int m = 0; m < 4; ++m) { unsigned char* rowp = O + (size_t)(row0 + ai * HALF + m * 16) * ldc + col0;
                u32x4 w;
                { const f32x4 v0 = acc[ai][0][m][0] + bv[0][0], v1 = acc[ai][0][m][1] + bv[0][1]; w.x = pk4_fp8(v0[0], v0[1], v0[2], v0[3]); w.y = pk4_fp8(v1[0], v1[1], v1[2], v1[3]); }
                { const f32x4 v0 = acc[ai][1][m][0] + bv[1][0], v1 = acc[ai][1][m][1] + bv[1][1]; w.z = pk4_fp8(v0[0], v0[1], v0[2], v0[3]); w.w = pk4_fp8(v1[0], v1[1], v1[2], v1[3]); }
                *(u32x4*)rowp = w; }
    }
};
struct EpiSwiglu {
    static constexpr bool PERM = true, BIAS = true, WIDE = false;
    unsigned char* O; const float* b1;
    DI const float* bias_src(const Unit& u, int idx0) const { return b1 + (size_t)u.e * 2048 + (idx0 < 128 ? u.pn * 128 + idx0 : 1024 + u.pn * 128 + (idx0 - 128)); }
    DI void operator()(const f32x4 (&acc)[2][2][4][2], const Unit& u, int wr, int wc, int fr, int fq, const LAS float* hb) const {
        const int row0 = u.pm * BM + wr * 64 + fr, x0 = wc * 32 + 8 * fq, col0 = u.pn * 128 + x0;
        f32x4 bg[2], bl[2];
#pragma unroll
        for (int n = 0; n < 2; ++n) { bg[n] = *(const LAS f32x4*)(hb + x0 + 4 * n); bl[n] = *(const LAS f32x4*)(hb + 128 + x0 + 4 * n) + 1.0f; }
        constexpr float KE = -1.702f * 1.4426950408889634f;
#pragma unroll
        for (int ai = 0; ai < 2; ++ai)
#pragma unroll
            for (int m = 0; m < 4; ++m) { unsigned char* rowp = O + (size_t)(row0 + ai * HALF + m * 16) * DFF + col0;
                float r[8];
#pragma unroll
                for (int n = 0; n < 2; ++n) { const f32x4 g4 = acc[ai][0][m][n] + bg[n], l4 = acc[ai][1][m][n] + bl[n];
#pragma unroll
                    for (int jp = 0; jp < 2; ++jp) {
                        f32x2 g = {fminf(g4[2 * jp], 7.0f), fminf(g4[2 * jp + 1], 7.0f)};
                        const f32x2 l1 = {__builtin_amdgcn_fmed3f(l4[2 * jp], -6.0f, 8.0f), __builtin_amdgcn_fmed3f(l4[2 * jp + 1], -6.0f, 8.0f)};
                        const f32x2 t = g * KE;
                        f32x2 e = {__builtin_amdgcn_exp2f(t.x), __builtin_amdgcn_exp2f(t.y)};
                        e = e + 1.0f;
                        const f32x2 s = {__builtin_amdgcn_rcpf(e.x), __builtin_amdgcn_rcpf(e.y)};
                        const f32x2 o2 = (g * s) * l1;
                        r[4 * n + 2 * jp] = o2.x; r[4 * n + 2 * jp + 1] = o2.y; } }
                u32x2 w; w.x = pk4_fp8(r[0], r[1], r[2], r[3]); w.y = pk4_fp8(r[4], r[5], r[6], r[7]);
                *(u32x2*)rowp = w; }
    }
};
struct EpiLogits {
    static constexpr bool PERM = false, BIAS = false, WIDE = false;
    float* LG; const float* rb;
    DI const float* bias_src(const Unit&, int) const { return nullptr; }
    DI void operator()(const f32x4 (&acc)[2][2][4][2], const Unit& u, int wr, int wc, int fr, int fq, const LAS float*) const {
        if (wc != 0) return;
        const int row0 = u.pm * BM + wr * 64 + fr;
#pragma unroll
        for (int n = 0; n < 2; ++n) { const f32x4 bv = *(const f32x4*)(rb + 16 * n + 4 * fq);
#pragma unroll
            for (int ai = 0; ai < 2; ++ai)
#pragma unroll
                for (int m = 0; m < 4; ++m) *(f32x4*)(LG + (size_t)(row0 + ai * HALF + m * 16) * 32 + 16 * n + 4 * fq) = acc[ai][0][m][n] + bv; }
    }
};
}
struct Params { const float* in[27]; float* out; unsigned char* ws; };
enum { I_X = 0, I_C, I_CTX, I_CCTX, I_ADAW, I_ADAB, I_MIXPRE, I_MIXPOST, I_FFNPRE, I_FFNPOST, I_EWIN, I_DLAM, I_SUBLN, I_QNG, I_WQB, I_KVNG, I_WKVB, I_EWOUT,
       I_NAQKV, I_NARPB, I_NAWOUT, I_RW, I_RB, I_W1, I_B1, I_W2, I_B2 };

template <class T> DI T* rfl_ptr(T* p) { const unsigned long long v = (unsigned long long)p; const unsigned lo = __builtin_amdgcn_readfirstlane((unsigned)v), hi = __builtin_amdgcn_readfirstlane((unsigned)(v >> 32)); return (T*)(((unsigned long long)hi << 32) | lo); }
template <class T> DI T* launder(T* p) { const unsigned long long v = (unsigned long long)p; unsigned lo = (unsigned)v, hi = (unsigned)(v >> 32); asm volatile("" : "+v"(lo), "+v"(hi)); lo = __builtin_amdgcn_readfirstlane(lo); hi = __builtin_amdgcn_readfirstlane(hi);
    typedef __attribute__((address_space(1))) T GT; GT* g = (GT*)(((unsigned long long)hi << 32) | lo); return (T*)g; }
struct Ctx {
    const Params* prm; float* out; unsigned char* ws; LAS unsigned char* lds;
    DI const float* in(int i) const { return prm->in[i]; }
    int tid, lane, wave, G, blk, gw, NGW, vcu;

    DI float* xc() const { return (float*)(ws + WS_XC); }
    DI float* mod(int l, int bidx) const { return (float*)(ws + WS_MOD) + ((size_t)l * 33 + bidx) * 6144; }
    DI bf16_t* H() const { return (bf16_t*)(ws + WS_H); }
    DI unsigned* misc() const { return (unsigned*)(ws + WS_MISC); }
    DI unsigned* ctl() const { return (unsigned*)(ws + WS_CTL); }
    template <class T> DI T* r(size_t off) const { return (T*)(ws + WS_R + off); }
};

DI Ctx mk_ctx(const Params& prm, LAS unsigned char* lds) {
    Ctx c;
    c.prm = &prm; c.out = launder(prm.out); c.ws = launder(prm.ws); c.lds = lds;
    int t = threadIdx.x; asm volatile("" : "+v"(t));
    c.tid = t; c.lane = t & 63; c.wave = __builtin_amdgcn_readfirstlane(t >> 6);
    c.G = gridDim.x; c.blk = blockIdx.x; c.gw = c.blk * NWAVES + c.wave; c.NGW = c.G * NWAVES;
    c.vcu = (c.G % 8 == 0) ? (c.blk % 8) * (c.G / 8) + c.blk / 8 : c.blk;
    return c;
}
DI float* xrow(const Ctx& c, int m) { return m < TL ? c.out + (size_t)m * DM : c.xc() + (size_t)(m - TL) * DM; }
DI const float* xin_row(const Ctx& c, int m) { return m < TL ? c.in(I_X) + (size_t)m * DM : c.in(I_CTX) + (size_t)(m - TL) * DM; }
DI int mod_idx(int m) { return m < TL ? (m >> 11) : 32; }

DI void transpose_item(const float* W, int K, int N, bf16_t* WT, int row_off, LAS float* scr, int item, int lane) {
    const int nblk = N / 32, kb = item / nblk, nb = item % nblk, k0 = 64 * kb, n0 = 32 * nb;
    float wv[32];
#pragma unroll
    for (int i = 0; i < 32; ++i) wv[i] = W[(size_t)(k0 + 2 * i + (lane >> 5)) * N + n0 + (lane & 31)];
#pragma unroll
    for (int i = 0; i < 32; ++i) scr[(2 * i + (lane >> 5)) * 33 + (lane & 31)] = wv[i];
    LDS_WAIT(); asm volatile("" ::: "memory");
    const int cch = lane & 7;
#pragma unroll
    for (int j = 0; j < 4; ++j) { const int n = (lane >> 3) + 8 * j; const LAS float* s = scr + (8 * cch) * 33 + n;
        u32x4 o; o.x = pk2(s[0 * 33], s[1 * 33]); o.y = pk2(s[2 * 33], s[3 * 33]); o.z = pk2(s[4 * 33], s[5 * 33]); o.w = pk2(s[6 * 33], s[7 * 33]);
        *(u32x4*)(WT + (size_t)(row_off + n0 + n) * K + k0 + 8 * cch) = o; }
    LDS_WAIT(); asm volatile("" ::: "memory");
}

DI void f8_item_load(const float* W, int N, int item, int lane, float (&wv)[32]) {
    const int nblk = N / 32, kb = item / nblk, nb = item % nblk, k0 = 64 * kb, n0 = 32 * nb;
#pragma unroll
    for (int i = 0; i < 32; ++i) wv[i] = W[(size_t)(k0 + 2 * i + (lane >> 5)) * N + n0 + (lane & 31)];
}
DI void f8_item_finish(const float (&wv)[32], int K, int N, unsigned char* WT, LAS float* scr, int item, int lane) {
    const int nblk = N / 32, kb = item / nblk, nb = item % nblk, k0 = 64 * kb, n0 = 32 * nb;
#pragma unroll
    for (int i = 0; i < 32; ++i) scr[(2 * i + (lane >> 5)) * 33 + (lane & 31)] = wv[i];
    LDS_WAIT(); asm volatile("" ::: "memory");
    const int cch = lane & 3;
#pragma unroll
    for (int j = 0; j < 2; ++j) { const int n = (lane >> 2) + 16 * j; const LAS float* s = scr + (16 * cch) * 33 + n;
        u32x4 o;
        o.x = pk4_fp8(32.f * s[0 * 33], 32.f * s[1 * 33], 32.f * s[2 * 33], 32.f * s[3 * 33]);
        o.y = pk4_fp8(32.f * s[4 * 33], 32.f * s[5 * 33], 32.f * s[6 * 33], 32.f * s[7 * 33]);
        o.z = pk4_fp8(32.f * s[8 * 33], 32.f * s[9 * 33], 32.f * s[10 * 33], 32.f * s[11 * 33]);
        o.w = pk4_fp8(32.f * s[12 * 33], 32.f * s[13 * 33], 32.f * s[14 * 33], 32.f * s[15 * 33]);
        *(u32x4*)(WT + (size_t)(n0 + n) * K + k0 + 16 * cch) = o; }
    LDS_WAIT(); asm volatile("" ::: "memory");
}
DI void transpose_item_f8(const float* W, int K, int N, unsigned char* WT, LAS float* scr, int item, int lane) {
    float wv[32];
    f8_item_load(W, N, item, lane, wv);
    f8_item_finish(wv, K, N, WT, scr, item, lane);
}

DI void p0a_tables(const Ctx& c) {
    float* sct = (float*)(c.ws + WS_SCT);
    const int gt = c.blk * NTHREADS + c.tid, NGT = c.G * NTHREADS;
    for (int i = gt; i < 33 * 1024; i += NGT) { const int b = i >> 10, k = i & 1023;
        const float v = b < 32 ? c.in(I_C)[b * 1024 + k] : c.in(I_CCTX)[k];
        sct[k * 40 + b] = v / (1.0f + __expf(-v)); }
    float* rope = (float*)(c.ws + WS_ROPE);
    for (int i = gt; i < 64 * 16; i += NGT) { const int pos = i >> 4, f = i & 15;
        const float inv = exp2f(-(float)f * (13.287712379549449f / 16.0f));
        const float ang = (float)pos * inv; rope[2 * i] = __cosf(ang); rope[2 * i + 1] = __sinf(ang); }
    if (c.blk == 0 && c.wave == 0) {
        const float* dl = c.in(I_DLAM);
        const float a = wave_sum(dl[c.lane] * dl[64 + c.lane]), b = wave_sum(dl[128 + c.lane] * dl[192 + c.lane]);
        if (c.lane == 0) ((float*)c.misc())[MW_LAM] = __expf(a) - __expf(b) + 0.2f;
    }
}

DI void modvec_item(const Ctx& c, int item) {
    const int l = item / 96, cg = item % 96, col = cg * 64 + c.lane;
    const float* W = c.in(I_ADAW) + (size_t)l * 1024 * 6144 + col;
    const float* sct = (const float*)(c.ws + WS_SCT);
    float acc[33];
#pragma unroll
    for (int b = 0; b < 33; ++b) acc[b] = 0.f;
    const int k0 = c.wave * 128;
#pragma unroll 1
    for (int kk0 = 0; kk0 < 128; kk0 += 32) {
        float wv[32];
#pragma unroll
        for (int i = 0; i < 32; ++i) wv[i] = W[(size_t)(k0 + kk0 + i) * 6144];
#pragma unroll
        for (int g = 0; g < 8; ++g) {
#pragma unroll
            for (int i = 0; i < 4; ++i) { const float* s = sct + (k0 + kk0 + 4 * g + i) * 40;
#pragma unroll
                for (int b = 0; b < 33; ++b) acc[b] = fmaf(s[b], wv[4 * g + i], acc[b]); }
            __builtin_amdgcn_sched_barrier(0);
        }
    }
    LAS float* red = (LAS float*)c.lds;
#pragma unroll
    for (int b = 0; b < 33; ++b) red[(c.wave * 33 + b) * 64 + c.lane] = acc[b];
    __syncthreads();
    for (int o = c.tid; o < 33 * 64; o += NTHREADS) { const int b = o >> 6, cc = o & 63; float s = 0.f;
#pragma unroll
        for (int w = 0; w < 8; ++w) s += red[(w * 33 + b) * 64 + cc];
        c.mod(l, b)[cg * 64 + cc] = s + c.in(I_ADAB)[l * 6144 + cg * 64 + cc]; }
    __syncthreads();
}

DI void p0b_weights(const Ctx& c) {
    for (int it = c.blk; it < 192; it += c.G) modvec_item(c, it);
    LAS float* scr = (LAS float*)(c.lds + c.wave * 16384);
    const int I_IN = 16 * 62, I_QB = 4 * 24, I_KVB = 2 * 32, I_OUT = 16 * 32, I_QKV = 16 * 96, I_NAO = 16 * 32, I_R = 2 * 16, I_1 = 64 * 16 * 64, I_2 = 64 * 16 * 32;
    const int NIT = I_IN + I_QB + I_KVB + I_OUT + I_QKV + I_NAO + I_R + I_1 + I_2;
    unsigned char* ws = c.ws;
    int it = c.gw;
    { const int I_12 = I_1 + I_2;
      const float* w1 = c.in(I_W1); const float* w2 = c.in(I_W2);
      auto src = [&](int r, const float*& W, int& N, unsigned char*& WT, int& q) {
          if (r < I_1) { const int mtx = r >> 10; q = r & 1023; W = w1 + (size_t)mtx * 1024 * 2048; N = 2048; WT = ws + WS_W1 + (size_t)mtx * 2048 * 1024; }
          else { r -= I_1; const int mtx = r >> 9; q = r & 511; W = w2 + (size_t)mtx * 1024 * 1024; N = 1024; WT = ws + WS_W2 + (size_t)mtx * 1024 * 1024; } };
      float nv[32]; const float* W; int N, q; unsigned char* WT;
      if (it < I_12) { src(it, W, N, WT, q); f8_item_load(W, N, q, c.lane, nv); }
#pragma unroll 1
      for (; it < I_12; it += c.NGW) {
          float wv[32];
#pragma unroll
          for (int i = 0; i < 32; ++i) wv[i] = nv[i];
          const int cN = N, cq = q; unsigned char* const cWT = WT;
          if (it + c.NGW < I_12) { src(it + c.NGW, W, N, WT, q); f8_item_load(W, N, q, c.lane, nv); }
          f8_item_finish(wv, 1024, cN, cWT, scr, cq, c.lane);
      } }
    for (; it < NIT; it += c.NGW) {
        int r = it - (I_1 + I_2);
        if (r < I_IN) { transpose_item_f8(c.in(I_EWIN), 1024, EVEN_IN_W, ws + WS_WIN, scr, r, c.lane); continue; } r -= I_IN;
        if (r < I_QB) { transpose_item(c.in(I_WQB), 256, 768, (bf16_t*)(ws + WS_WQB), 0, scr, r, c.lane); continue; } r -= I_QB;
        if (r < I_KVB) { transpose_item(c.in(I_WKVB), 128, 1024, (bf16_t*)(ws + WS_WKVB), 0, scr, r, c.lane); continue; } r -= I_KVB;
        if (r < I_OUT) { transpose_item(c.in(I_EWOUT), 1024, 1024, (bf16_t*)(ws + WS_WOUT), 0, scr, r, c.lane); continue; } r -= I_OUT;
        if (r < I_QKV) { transpose_item_f8(c.in(I_NAQKV), 1024, 3072, ws + WS_WQKV, scr, r, c.lane); continue; } r -= I_QKV;
        if (r < I_NAO) { transpose_item(c.in(I_NAWOUT), 1024, 1024, (bf16_t*)(ws + WS_WNAO), 0, scr, r, c.lane); continue; } r -= I_NAO;
        { const int l = r >> 4, q = r & 15; transpose_item(c.in(I_RW) + (size_t)l * 1024 * 32, 1024, 32, (bf16_t*)(ws + WS_WR) + (size_t)l * 256 * 1024, 0, scr, q, c.lane); }
    }
    const int gt = c.blk * NTHREADS + c.tid, NGT = c.G * NTHREADS;
    { u32x4* p = (u32x4*)(ws + WS_WIN + (size_t)EVEN_IN_W * 1024); for (int i = gt; i < 64 * 1024 / 16; i += NGT) p[i] = (u32x4){0u, 0u, 0u, 0u}; }
    for (int l = 0; l < 2; ++l) { u32x4* p = (u32x4*)((bf16_t*)(ws + WS_WR) + (size_t)l * 256 * 1024 + 32 * 1024); for (int i = gt; i < 224 * 1024 / 8; i += NGT) p[i] = (u32x4){0u, 0u, 0u, 0u}; }
}

DI void load_row_f32(const float* p, int lane, f32x4 (&v)[4]) {
#pragma unroll
    for (int j = 0; j < 4; ++j) v[j] = ((const f32x4*)p)[lane + 64 * j];
}
DI void load_row_bf16(const bf16_t* p, int lane, f32x4 (&v)[4]) {
#pragma unroll
    for (int j = 0; j < 4; ++j) { const u32x2 w = ((const u32x2*)p)[lane + 64 * j]; v[j] = (f32x4){bflo(w.x), bfhi(w.x), bflo(w.y), bfhi(w.y)}; }
}
DI void store_row_bf16(bf16_t* p, int lane, const f32x4 (&v)[4]) {
#pragma unroll
    for (int j = 0; j < 4; ++j) { u32x2 w; w.x = pk2(v[j][0], v[j][1]); w.y = pk2(v[j][2], v[j][3]); ((u32x2*)p)[lane + 64 * j] = w; }
}
DI float row_rstd(const f32x4 (&v)[4]) {
    float s = 0.f;
#pragma unroll
    for (int j = 0; j < 4; ++j) s += (v[j][0] * v[j][0] + v[j][1] * v[j][1]) + (v[j][2] * v[j][2] + v[j][3] * v[j][3]);
    return __builtin_amdgcn_rsqf(wave_sum(s) * (1.0f / DM) + EPS);
}
DI void norm_mod_store(const f32x4 (&x)[4], const float* g, const float* shift, const float* scale, bf16_t* dst, int lane, unsigned char* dst8 = nullptr) {
    const float rstd = row_rstd(x); f32x4 h[4];
#pragma unroll
    for (int j = 0; j < 4; ++j) { const f32x4 gg = ((const f32x4*)g)[lane + 64 * j], sh = ((const f32x4*)shift)[lane + 64 * j], sc = ((const f32x4*)scale)[lane + 64 * j];
        h[j] = x[j] * rstd * gg * (sc + 1.0f) + sh; }
    if (dst) store_row_bf16(dst, lane, h);
    if (dst8) {
#pragma unroll
        for (int j = 0; j < 4; ++j) ((unsigned*)dst8)[lane + 64 * j] = pk4_fp8(h[j][0], h[j][1], h[j][2], h[j][3]); }
}

DI void norm_mod_store_lds(const f32x4 (&x)[4], const LAS float* g, const LAS float* shift, const LAS float* scale, int lane, unsigned char* dst8) {
    f32x4 qg[4], qh[4], qc[4];
#pragma unroll
    for (int j = 0; j < 4; ++j) { qg[j] = ((const LAS f32x4*)g)[lane + 64 * j]; qh[j] = ((const LAS f32x4*)shift)[lane + 64 * j]; qc[j] = ((const LAS f32x4*)scale)[lane + 64 * j]; }
    __builtin_amdgcn_sched_barrier(0);
    const float rstd = row_rstd(x);
#pragma unroll
    for (int j = 0; j < 4; ++j) { const f32x4 h = x[j] * rstd * qg[j] * (qc[j] + 1.0f) + qh[j];
        ((unsigned*)dst8)[lane + 64 * j] = pk4_fp8(h[0], h[1], h[2], h[3]); }
}
DI void p_prenorm0(const Ctx& c) {
    const int per = (((TT + c.G - 1) / c.G) + 7) & ~7, base = c.blk * per, t0 = base + c.wave, nk = per >> 3;
    LAS float* Pm = (LAS float*)c.lds;
    const int b0 = mod_idx(min(base, TT - 1)), b1 = mod_idx(min(base + per - 1, TT - 1));
    { const float* g = c.in(I_MIXPRE); const float* m0 = c.mod(0, b0); const float* m1 = c.mod(0, b1);
      for (int i = c.tid; i < 1024; i += NTHREADS) { Pm[i] = g[i]; Pm[1024 + i] = m0[i]; Pm[2048 + i] = m0[1024 + i]; Pm[3072 + i] = m1[i]; Pm[4096 + i] = m1[1024 + i]; } }
    __syncthreads();
    f32x4 nx[4][4];
#pragma unroll
    for (int r = 0; r < 4; ++r) load_row_f32(xin_row(c, min(t0 + 8 * r, TT - 1)), c.lane, nx[r]);
#pragma unroll 1
    for (int k = 0;; k += 4) {
        f32x4 x[4][4];
#pragma unroll
        for (int r = 0; r < 4; ++r)
#pragma unroll
            for (int j = 0; j < 4; ++j) x[r][j] = nx[r][j];
        if (k + 4 < nk) {
#pragma unroll
            for (int r = 0; r < 4; ++r) load_row_f32(xin_row(c, min(t0 + 8 * (k + 4 + r), TT - 1)), c.lane, nx[r]); }
#pragma unroll
        for (int r = 0; r < 4; ++r) { const int m = t0 + 8 * (k + r); if (k + r < nk && m < TT) { const LAS float* ms = Pm + 1024 + (mod_idx(m) == b0 ? 0 : 2048);
            norm_mod_store_lds(x[r], Pm, ms, ms + 1024, c.lane, c.ws + WS_H8 + (size_t)m * DM); } }
        if (k + 4 >= nk) break;
    }
}

DI void postmix_row(const Ctx& c, int l, int m, const f32x4 (&y)[4], f32x4 (&x)[4]) {
    const float* md = c.mod(l, mod_idx(m));
    const float rstd = row_rstd(y);
    const float* g = c.in(I_MIXPOST) + l * DM;
#pragma unroll
    for (int j = 0; j < 4; ++j) { const f32x4 gg = ((const f32x4*)g)[c.lane + 64 * j], gate = ((const f32x4*)(md + 2048))[c.lane + 64 * j];
        x[j] = x[j] + gate * (y[j] * rstd * gg); }
    float* xo = xrow(c, m);
#pragma unroll
    for (int j = 0; j < 4; ++j) ((f32x4*)xo)[c.lane + 64 * j] = x[j];
    norm_mod_store(x, c.in(I_FFNPRE) + l * DM, md + 3 * 1024, md + 4 * 1024, c.H() + (size_t)m * DM, c.lane, c.ws + WS_H8 + (size_t)m * DM);
}
DI void p_postmix(const Ctx& c, int l, int nrows) {
    const bf16_t* Y = c.r<bf16_t>(R_Y);
    for (int m0 = c.gw; m0 < nrows; m0 += 2 * c.NGW) {
        const int m1 = m0 + c.NGW; const bool ok1 = m1 < nrows;
        f32x4 y0[4], x0[4], y1[4], x1[4];
        load_row_bf16(Y + (size_t)m0 * DM, c.lane, y0);
        if (l == 0) load_row_f32(xin_row(c, m0), c.lane, x0); else load_row_f32(xrow(c, m0), c.lane, x0);
        if (ok1) { load_row_bf16(Y + (size_t)m1 * DM, c.lane, y1);
            if (l == 0) load_row_f32(xin_row(c, m1), c.lane, x1); else load_row_f32(xrow(c, m1), c.lane, x1); }
        postmix_row(c, l, m0, y0, x0);
        if (ok1) postmix_row(c, l, m1, y1, x1);
    }
}

struct FfnRow { unsigned e[4][4]; f32x4 x[4]; f32x4 tw; };
DI void postffn_load(const Ctx& c, int m, const u32x4 sl, FfnRow& R) {
    const unsigned char* EO = c.r<unsigned char>(R_EO);
    R.tw = *(const f32x4*)(c.r<float>(R_TOPW) + (size_t)m * 4);
    const unsigned s[4] = {sl.x, sl.y, sl.z, sl.w};
#pragma unroll
    for (int k = 0; k < 4; ++k)
#pragma unroll
        for (int j = 0; j < 4; ++j) R.e[k][j] = ((const unsigned*)(EO + (size_t)s[k] * DM))[c.lane + 64 * j];
    load_row_f32(xrow(c, m), c.lane, R.x);
}
DI void postffn_row(const Ctx& c, int l, int m, bool last, FfnRow& R, const LAS float* Pm, int b0) {
    f32x4 y[4];
#pragma unroll
    for (int j = 0; j < 4; ++j) { y[j] = (f32x4){0.f, 0.f, 0.f, 0.f};
#pragma unroll
        for (int k = 0; k < 4; ++k) { const unsigned w = R.e[k][j]; const f32x2 lo = __builtin_amdgcn_cvt_pk_f32_fp8((int)w, false), hi = __builtin_amdgcn_cvt_pk_f32_fp8((int)w, true);
            y[j] += (f32x4){lo.x, lo.y, hi.x, hi.y} * R.tw[k]; } }
    const LAS float* ms = Pm + 2048 + (mod_idx(m) == b0 ? 0 : 3072);
    f32x4 pg[4], pt[4];
#pragma unroll
    for (int j = 0; j < 4; ++j) { pg[j] = ((const LAS f32x4*)Pm)[c.lane + 64 * j]; pt[j] = ((const LAS f32x4*)ms)[c.lane + 64 * j]; }
    __builtin_amdgcn_sched_barrier(0);
    const float rstd = row_rstd(y);
#pragma unroll
    for (int j = 0; j < 4; ++j) R.x[j] = R.x[j] + pt[j] * (y[j] * rstd * pg[j]);
    if (last || m < TL) {
        float* xo = xrow(c, m);
#pragma unroll
        for (int j = 0; j < 4; ++j) ((f32x4*)xo)[c.lane + 64 * j] = R.x[j]; }
    if (!last) norm_mod_store_lds(R.x, Pm + 1024, ms + 1024, ms + 2048, c.lane, c.ws + WS_H8 + (size_t)m * DM);
}
DI void p_postffn(const Ctx& c, int l, int nrows, bool last) {
    const unsigned* slot = c.r<unsigned>(R_SLOT);
    const int per = (((nrows + c.G - 1) / c.G) + 7) & ~7, base = c.blk * per, t0 = base + c.wave, nk = per >> 3, lastrow = nrows - 1;
    LAS float* Pm = (LAS float*)c.lds;
    const int b0 = mod_idx(min(base, lastrow)), b1 = mod_idx(min(base + per - 1, lastrow));
    { const float* g = c.in(I_FFNPOST) + l * DM; const float* gn = c.in(I_MIXPRE) + (last ? l : l + 1) * DM;
      for (int i = c.tid; i < 1024; i += NTHREADS) { Pm[i] = g[i]; Pm[1024 + i] = gn[i];
#pragma unroll
          for (int s = 0; s < 2; ++s) { const int bs = s ? b1 : b0; Pm[2048 + 3072 * s + i] = c.mod(l, bs)[5 * 1024 + i];
              if (!last) { const float* md1 = c.mod(l + 1, bs); Pm[2048 + 3072 * s + 1024 + i] = md1[i]; Pm[2048 + 3072 * s + 2048 + i] = md1[1024 + i]; } } } }
    __syncthreads();
    auto ldslot = [&](int k) { return *(const u32x4*)(slot + (size_t)min(t0 + 8 * k, lastrow) * 4); };
    FfnRow A, B;
    u32x4 nsA, nsB;
    { const u32x4 s0 = ldslot(0), s1 = ldslot(1); nsA = ldslot(2); nsB = ldslot(3);
      postffn_load(c, min(t0, lastrow), s0, A); postffn_load(c, min(t0 + 8, lastrow), s1, B); }
#pragma unroll 1
    for (int k = 0;; k += 2) {
        const int m0 = t0 + 8 * k, m1 = m0 + 8;
        const u32x4 fsA = ldslot(k + 4), fsB = ldslot(k + 5);
        FfnRow A2, B2;
        postffn_load(c, min(m0 + 16, lastrow), nsA, A2); postffn_load(c, min(m0 + 24, lastrow), nsB, B2);
        if (m0 < nrows) postffn_row(c, l, m0, last, A, Pm, b0);
        if (k + 1 < nk && m1 < nrows) postffn_row(c, l, m1, last, B, Pm, b0);
        if (k + 2 >= nk) break;
        A = A2; B = B2; nsA = fsA; nsB = fsB;
    }
}

template <typename CS>
DI void rope8(f32x4& lo, f32x4& hi, const float (&plo)[8], const float (&phi)[8], bool upper, CS cs) {
    float v[8] = {lo[0], lo[1], lo[2], lo[3], hi[0], hi[1], hi[2], hi[3]};
#pragma unroll
    for (int e = 0; e < 8; ++e) { const float co = cs[2 * e], si = cs[2 * e + 1]; const float p = e < 4 ? plo[e] : phi[e];
        v[e] = upper ? (v[e] * co + p * si) : (v[e] * co - p * si); }
    lo = (f32x4){v[0], v[1], v[2], v[3]}; hi = (f32x4){v[4], v[5], v[6], v[7]};
}
DI void p_even_post_inproj(const Ctx& c) {
    bf16_t* P = c.r<bf16_t>(R_P); bf16_t* CQN = c.r<bf16_t>(R_CQN); bf16_t* CKVN = c.r<bf16_t>(R_CKVN); bf16_t* KVX = c.r<bf16_t>(R_KVX);
    LAS float* rope = (LAS float*)(c.lds + LDSCTL_OFF + 8192);
    { const f32x4* src = (const f32x4*)(c.ws + WS_ROPE); ((LAS f32x4*)rope)[c.tid] = src[c.tid]; }
    __syncthreads();
    const int lane = c.lane, a = lane & 7;
    const float* gp = lane < 32 ? c.in(I_QNG) + 8 * lane : c.in(I_KVNG) + 8 * ((lane - 32) & 15);
    const f32x4 g0 = *(const f32x4*)gp, g1 = *(const f32x4*)(gp + 4);
    const int n = c.gw < TT ? (TT - c.gw + c.NGW - 1) / c.NGW : 0;
    auto ld = [&](int k) { const int mm = min(c.gw + k * c.NGW, TT - 1); return ((const u32x4*)(P + (size_t)mm * EVEN_IN_PAD))[lane + 192]; };
    u32x4 wq[8];
#pragma unroll
    for (int i = 0; i < 8; ++i) wq[i] = ld(i);
#pragma unroll 1
    for (int k = 0; k < n; k += 8) {
#pragma unroll
      for (int i = 0; i < 8; ++i) {
        u32x4 w = wq[i]; wq[i] = ld(k + 8 + i);
        if (k + i >= n) continue;
        const int m = c.gw + (k + i) * c.NGW;
        const bool lat = m < TL; const int s = m & 2047, prow = s >> 6, pcol = s & 63;
        const int pos = (a < 4) ? prow : pcol; const bool upper = (a & 2) != 0;
        const LAS float* cs = rope + (pos * 16 + (a & 1) * 8) * 2;
        {
            f32x4 lo = {bflo(w.x), bfhi(w.x), bflo(w.y), bfhi(w.y)}, hi = {bflo(w.z), bfhi(w.z), bflo(w.w), bfhi(w.w)};
            float ss = (lo[0] * lo[0] + lo[1] * lo[1]) + (lo[2] * lo[2] + lo[3] * lo[3]) + (hi[0] * hi[0] + hi[1] * hi[1]) + (hi[2] * hi[2] + hi[3] * hi[3]);
            const float s16 = row16_sum(ss);
            float s32; { auto r = __builtin_amdgcn_permlane16_swap(__float_as_uint(s16), __float_as_uint(s16), false, false); s32 = __uint_as_float(r[0]) + __uint_as_float(r[1]); }
            float plo[8], phi[8];
#pragma unroll
            for (int e = 0; e < 4; ++e) { plo[e] = dppf<0x4E>(lo[e]); phi[4 + e] = dppf<0x4E>(hi[e]); plo[4 + e] = 0.f; phi[e] = 0.f; }
            if (lane < 32) {
                const float rstd = __builtin_amdgcn_rsqf(s32 * (1.0f / 256.0f) + EPS);
                u32x4 o; o.x = pk2(lo[0] * rstd * g0[0], lo[1] * rstd * g0[1]); o.y = pk2(lo[2] * rstd * g0[2], lo[3] * rstd * g0[3]);
                o.z = pk2(hi[0] * rstd * g1[0], hi[1] * rstd * g1[1]); o.w = pk2(hi[2] * rstd * g1[2], hi[3] * rstd * g1[3]);
                *(u32x4*)(CQN + (size_t)m * 256 + 8 * lane) = o;
            } else if (lane < 48) {
                const float rstd = __builtin_amdgcn_rsqf(s16 * (1.0f / 128.0f) + EPS);
                u32x4 o; o.x = pk2(lo[0] * rstd * g0[0], lo[1] * rstd * g0[1]); o.y = pk2(lo[2] * rstd * g0[2], lo[3] * rstd * g0[3]);
                o.z = pk2(hi[0] * rstd * g1[0], hi[1] * rstd * g1[1]); o.w = pk2(hi[2] * rstd * g1[2], hi[3] * rstd * g1[3]);
                *(u32x4*)(CKVN + (size_t)m * 128 + 8 * (lane - 32)) = o;
            } else if (lane < 56) {
                if (lat) { rope8(lo, hi, plo, phi, upper, cs); w.x = pk2(lo[0], lo[1]); w.y = pk2(lo[2], lo[3]); w.z = pk2(hi[0], hi[1]); w.w = pk2(hi[2], hi[3]); }
                bf16_t* kd = KVX + (size_t)m * 1280 + 128 + 8 * (lane - 48);
#pragma unroll
                for (int h = 0; h < 4; ++h) *(u32x4*)(kd + h * 320) = w;
            }
        }
      }
    }
}
DI void p_rope_qpe(const Ctx& c) {
    bf16_t* QM = c.r<bf16_t>(R_QM); const float* rope = (const float*)(c.ws + WS_ROPE);
    const int lane = c.lane, a = lane & 7, h = (lane >> 3) & 3, half = lane >> 5;
    for (int m2 = c.gw; m2 < TL / 2; m2 += c.NGW) {
        const int m = 2 * m2 + half, s = m & 2047, prow = s >> 6, pcol = s & 63;
        const int pos = (a < 4) ? prow : pcol; const bool upper = (a & 2) != 0;
        const float* cs = rope + (pos * 16 + (a & 1) * 8) * 2;
        u32x4* p = (u32x4*)(QM + (size_t)m * 768 + h * 192 + 128 + 8 * a);
        u32x4 w = *p;
        f32x4 lo = {bflo(w.x), bfhi(w.x), bflo(w.y), bfhi(w.y)}, hi = {bflo(w.z), bfhi(w.z), bflo(w.w), bfhi(w.w)};
        float plo[8], phi[8];
#pragma unroll
        for (int e = 0; e < 4; ++e) { plo[e] = dppf<0x4E>(lo[e]); phi[4 + e] = dppf<0x4E>(hi[e]); plo[4 + e] = 0.f; phi[e] = 0.f; }
        rope8(lo, hi, plo, phi, upper, cs);
        w.x = pk2(lo[0], lo[1]); w.y = pk2(lo[2], lo[3]); w.z = pk2(hi[0], hi[1]); w.w = pk2(hi[2], hi[3]);
        *p = w;
    }
}
DI void p_diff_merge(const Ctx& c) {
    const bf16_t* AO = c.r<bf16_t>(R_AO); bf16_t* AOM = c.r<bf16_t>(R_AOM);
    const float lam = ((const float*)c.misc())[MW_LAM];
    const f32x2 g = ((const f32x2*)c.in(I_SUBLN))[c.lane];
    const int step = 4 * c.NGW;
    int m0 = c.gw;
    if (m0 >= TT) return;
    unsigned nw[4][8];
#pragma unroll
    for (int r = 0; r < 4; ++r) { const unsigned* a = (const unsigned*)(AO + (size_t)min(m0 + r * c.NGW, TT - 1) * 1024);
#pragma unroll
        for (int q = 0; q < 8; ++q) nw[r][q] = a[q * 64 + c.lane]; }
#pragma unroll 1
    for (;; m0 += step) {
        unsigned w[4][8]; int mr[4];
#pragma unroll
        for (int r = 0; r < 4; ++r) { mr[r] = m0 + r * c.NGW;
#pragma unroll
            for (int q = 0; q < 8; ++q) w[r][q] = nw[r][q]; }
        if (m0 + step < TT) {
#pragma unroll
            for (int r = 0; r < 4; ++r) { const unsigned* a = (const unsigned*)(AO + (size_t)min(m0 + step + r * c.NGW, TT - 1) * 1024);
#pragma unroll
                for (int q = 0; q < 8; ++q) nw[r][q] = a[q * 64 + c.lane]; } }
#pragma unroll
        for (int r = 0; r < 4; ++r) if (mr[r] < TT) {
            unsigned o[4];
#pragma unroll
            for (int hd = 0; hd < 4; ++hd) { const unsigned w1 = w[r][2 * hd], w2 = w[r][2 * hd + 1];
                const float d0 = bflo(w1) - lam * bflo(w2), d1 = bfhi(w1) - lam * bfhi(w2);
                const float rstd = __builtin_amdgcn_rsqf(wave_sum(d0 * d0 + d1 * d1) * (1.0f / 128.0f) + EPS);
                o[hd] = pk2(d0 * rstd * g.x * 0.8f, d1 * rstd * g.y * 0.8f); }
            unsigned* dst = (unsigned*)(AOM + (size_t)mr[r] * 1024);
#pragma unroll
            for (int hd = 0; hd < 4; ++hd) dst[hd * 64 + c.lane] = o[hd];
        }
        if (m0 + step >= TT) break;
    }
}
namespace att {
constexpr int NW = 8, QBLK = 32, KVBLK = 64, DV = 128;
constexpr float THR = 8.f;
constexpr int SHM_V = KVBLK * DV * 2;
#define SBAR() __builtin_amdgcn_sched_barrier(0)
DI int crow(int r, int hi) { return (r & 3) + 8 * (r >> 2) + 4 * hi; }
DI int v_st(int k, int c) { const int kk = (k & ~0xC) | ((k & 4) << 1) | ((k & 8) >> 1); return ((kk >> 3) * 4 + (c >> 5)) * 512 + ((kk & 7) * 32 + (c & 31)) * 2; }
DI int v_rd_base(int lane) { return ((lane & 3) << 3) | (((lane >> 2) & 3) << 6) | (((lane >> 4) & 1) << 5) | (((lane >> 5) & 1) << 8); }
constexpr int v_rd_off(int d0, int ks, int half) { return d0 * 512 + ks * 4096 + half * 2048; }
template <int OFF> DI s16x4 tr_read(int vb) { s16x4 r; asm volatile("ds_read_b64_tr_b16 %0, %1 offset:%2" : "=&v"(r) : "v"(vb), "i"(OFF) : "memory"); return r; }
template <int D0> DI void pv_one(f32x16& od, int vb, bf16x8 pa0, bf16x8 pa1, bf16x8 pa2, bf16x8 pa3) {
    const s16x4 l0 = tr_read<v_rd_off(D0, 0, 0)>(vb), h0 = tr_read<v_rd_off(D0, 0, 1)>(vb), l1 = tr_read<v_rd_off(D0, 1, 0)>(vb), h1 = tr_read<v_rd_off(D0, 1, 1)>(vb);
    const s16x4 l2 = tr_read<v_rd_off(D0, 2, 0)>(vb), h2 = tr_read<v_rd_off(D0, 2, 1)>(vb), l3 = tr_read<v_rd_off(D0, 3, 0)>(vb), h3 = tr_read<v_rd_off(D0, 3, 1)>(vb);
    asm volatile("s_waitcnt lgkmcnt(0)" ::: "memory"); SBAR();
#define ATT_PK(L, H) (bf16x8){L[0], L[1], L[2], L[3], H[0], H[1], H[2], H[3]}
    od = __builtin_amdgcn_mfma_f32_32x32x16_bf16(pa0, ATT_PK(l0, h0), od, 0, 0, 0);
    od = __builtin_amdgcn_mfma_f32_32x32x16_bf16(pa1, ATT_PK(l1, h1), od, 0, 0, 0);
    od = __builtin_amdgcn_mfma_f32_32x32x16_bf16(pa2, ATT_PK(l2, h2), od, 0, 0, 0);
    od = __builtin_amdgcn_mfma_f32_32x32x16_bf16(pa3, ATT_PK(l3, h3), od, 0, 0, 0);
#undef ATT_PK
}
DI void pv_d0(f32x16* o, int vb, bf16x8 pa0, bf16x8 pa1, bf16x8 pa2, bf16x8 pa3) {
    pv_one<0>(o[0], vb, pa0, pa1, pa2, pa3); pv_one<1>(o[1], vb, pa0, pa1, pa2, pa3); pv_one<2>(o[2], vb, pa0, pa1, pa2, pa3); pv_one<3>(o[3], vb, pa0, pa1, pa2, pa3);
}
DI void partialSM(f32x16& p0, f32x16& p1, float& m_reg, float& mn, float& alpha, float C, float thr_raw) {
    float pmax = p0[0];
#pragma unroll
    for (int r = 1; r < 16; ++r) pmax = fmaxf(pmax, p0[r]);
#pragma unroll
    for (int r = 0; r < 16; ++r) pmax = fmaxf(pmax, p1[r]);
    { auto rr = __builtin_amdgcn_permlane32_swap(__float_as_uint(pmax), __float_as_uint(pmax), false, false);
      pmax = fmaxf(__uint_as_float(rr[0]), __uint_as_float(rr[1])); }
    if (__builtin_expect(__all(pmax - m_reg <= thr_raw), 1)) { mn = m_reg; alpha = 1.f; }
    else { mn = fmaxf(m_reg, pmax); alpha = __builtin_amdgcn_exp2f((m_reg - mn) * C); m_reg = mn; }
    const float mnC = -mn * C;
#pragma unroll
    for (int r = 0; r < 16; ++r) p0[r] = fmaf(p0[r], C, mnC);
#pragma unroll
    for (int r = 0; r < 16; ++r) p1[r] = fmaf(p1[r], C, mnC);
#pragma unroll
    for (int r = 0; r < 16; ++r) p0[r] = __builtin_amdgcn_exp2f(p0[r]);
}
DI void finishSM(f32x16& p0, f32x16& p1, float alpha, float& l_reg, bf16x8& pa0, bf16x8& pa1, bf16x8& pa2, bf16x8& pa3) {
#pragma unroll
    for (int r = 0; r < 16; ++r) p1[r] = __builtin_amdgcn_exp2f(p1[r]);
    float ps = 0;
#pragma unroll
    for (int r = 0; r < 16; ++r) ps += p0[r];
#pragma unroll
    for (int r = 0; r < 16; ++r) ps += p1[r];
    { auto rr = __builtin_amdgcn_permlane32_swap(__float_as_uint(ps), __float_as_uint(ps), false, false);
      ps = __uint_as_float(rr[0]) + __uint_as_float(rr[1]); }
    l_reg = l_reg * alpha + ps;
#define ATT_PK4(P, BASE, OUT) do { unsigned a0 = cvt_pk_bf16(P[BASE + 0], P[BASE + 1]), a1 = cvt_pk_bf16(P[BASE + 2], P[BASE + 3]);   \
    unsigned b0 = cvt_pk_bf16(P[BASE + 4], P[BASE + 5]), b1 = cvt_pk_bf16(P[BASE + 6], P[BASE + 7]);                              \
    auto r0 = __builtin_amdgcn_permlane32_swap(a0, b0, false, false); auto r1 = __builtin_amdgcn_permlane32_swap(a1, b1, false, false); \
    u32x4 w = {r0[0], r1[0], r0[1], r1[1]}; OUT = *reinterpret_cast<bf16x8*>(&w); } while (0)
    ATT_PK4(p0, 0, pa0); ATT_PK4(p0, 8, pa1); ATT_PK4(p1, 0, pa2); ATT_PK4(p1, 8, pa3);
#undef ATT_PK4
}

template <int DQK> struct Geo {
    static constexpr int PITCH = DQK * 2, SHM_K = KVBLK * PITCH, NCH = DQK / 8, KCH = (KVBLK * NCH) / 512, ND0 = DQK / 16;
    static constexpr int LDS_NEED = 2 * SHM_V + 2 * SHM_K + NW * 64 * 4;
};
template <int DQK> DI int kswz(int row, int colB) { return row * Geo<DQK>::PITCH + (colB ^ ((row & 7) << 4)); }

template <int DQK, int SD>
DI void attn_unit(const bf16_t* __restrict__ Qb, int ldq, const bf16_t* __restrict__ Kb, int ldk, const bf16_t* __restrict__ Vb, int ldv, bf16_t* __restrict__ Ob, int ldo,
                  int qrow0, int lat0, int nlat, int ctx0, int NT, float scale, char* lds, int tid) {
    using G = Geo<DQK>;
    constexpr int SHM_K = G::SHM_K, KCH = G::KCH, NCH = G::NCH, ND0 = G::ND0;
    const float C = scale * 1.4426950408889634f, thr_raw = THR / scale;
    const int wid = tid >> 6, lane = tid & 63, r32 = lane & 31, hi = lane >> 5;
    char* V_lds = lds; char* K_lds = lds + 2 * SHM_V;
    float* wsf = (float*)(lds + 2 * SHM_V + 2 * SHM_K) + wid * 64; float* li_l = wsf; float* al_l = wsf + 32;
    float m_reg = -1e30f, l_reg = 0; f32x16 o[4] = {}; bf16x8 qr[ND0];
    const bf16_t* Qw = Qb + (size_t)(qrow0 + wid * QBLK + r32) * ldq + hi * 8;
#pragma unroll
    for (int d0 = 0; d0 < ND0; ++d0) qr[d0] = *(const bf16x8*)(Qw + d0 * 16);
    const int sr = tid >> 4, sc = (tid & 15) * 8, vst0 = v_st(sr, sc), vst1 = v_st(32 + sr, sc);
    int krow_[KCH], kcol_[KCH];
#pragma unroll
    for (int i = 0; i < KCH; ++i) { const int g = tid + 512 * i; krow_[i] = g / NCH; kcol_[i] = (g % NCH) * 8; }
    const int vb0 = (int)(uintptr_t)V_lds + v_rd_base(lane);
    struct { bf16x8 vs0, vs1, ks[KCH]; } sr_[SD];
#define KROW0(kt) ((kt) < nlat ? lat0 + (kt) * KVBLK : ctx0 + ((kt) - nlat) * KVBLK)
#define SLOAD(i, kt) do { const int _k0 = KROW0(kt); sr_[i].vs0 = *(const bf16x8*)(Vb + (size_t)(_k0 + sr) * ldv + sc); sr_[i].vs1 = *(const bf16x8*)(Vb + (size_t)(_k0 + 32 + sr) * ldv + sc); \
    _Pragma("unroll") for (int _c = 0; _c < KCH; ++_c) sr_[i].ks[_c] = *(const bf16x8*)(Kb + (size_t)(_k0 + krow_[_c]) * ldk + kcol_[_c]); } while (0)
#define SWRITE(b, i) do { *(bf16x8*)(V_lds + (b) * SHM_V + vst0) = sr_[i].vs0; *(bf16x8*)(V_lds + (b) * SHM_V + vst1) = sr_[i].vs1; \
    _Pragma("unroll") for (int _c = 0; _c < KCH; ++_c) *(bf16x8*)(K_lds + (b) * SHM_K + kswz<DQK>(krow_[_c], kcol_[_c] * 2)) = sr_[i].ks[_c]; } while (0)
#define SWAIT() do { if constexpr (SD == 2) { if constexpr (KCH == 1) asm volatile("s_waitcnt vmcnt(3)" ::: "memory"); else asm volatile("s_waitcnt vmcnt(5)" ::: "memory"); } \
    else asm volatile("s_waitcnt vmcnt(0)" ::: "memory"); } while (0)
#define RESC(a) do { if (__any((a) < 1.f)) { if (hi == 0) al_l[r32] = (a); asm volatile("s_waitcnt lgkmcnt(0)" ::: "memory"); \
    _Pragma("unroll") for (int d = 0; d < 4; ++d) _Pragma("unroll") for (int r = 0; r < 16; ++r) o[d][r] *= al_l[crow(r, hi)]; } } while (0)
#define QKT(p0, p1, Ks) do { p0 = f32x16{}; p1 = f32x16{}; _Pragma("unroll") for (int d0 = 0; d0 < ND0; ++d0) { const int cb = (d0 * 16 + hi * 8) * 2; \
    const bf16x8 b0 = *(const bf16x8*)((Ks) + kswz<DQK>(r32, cb)); const bf16x8 b1 = *(const bf16x8*)((Ks) + kswz<DQK>(32 + r32, cb)); \
    p0 = __builtin_amdgcn_mfma_f32_32x32x16_bf16(b0, qr[d0], p0, 0, 0, 0); p1 = __builtin_amdgcn_mfma_f32_32x32x16_bf16(b1, qr[d0], p1, 0, 0, 0); } } while (0)
    f32x16 pA0, pA1, pB0, pB1; float mnA, mnB, alA, alB; bf16x8 pa0, pa1, pa2, pa3;
    constexpr int SE = 0, SO = SD - 1;
    SLOAD(SE, 0); asm volatile("s_waitcnt vmcnt(0)" ::: "memory"); SWRITE(0, SE); __syncthreads();
    QKT(pA0, pA1, K_lds); partialSM(pA0, pA1, m_reg, mnA, alA, C, thr_raw);
    SLOAD(SO, 1); if constexpr (SD == 2) { if (2 < NT) SLOAD(SE, 2); }
    SWAIT(); SWRITE(1, SO); __syncthreads();
    for (int j = 1; j + 1 < NT; j += 2) {
        SBAR(); QKT(pB0, pB1, K_lds + SHM_K);
        finishSM(pA0, pA1, alA, l_reg, pa0, pa1, pa2, pa3); SBAR();
        SLOAD(SO, j + SD); SBAR();
        pv_d0(o, vb0, pa0, pa1, pa2, pa3); partialSM(pB0, pB1, m_reg, mnB, alB, C, thr_raw);
        __syncthreads(); SWAIT(); SWRITE(0, SE);
        RESC(alB); __syncthreads();
        SBAR(); QKT(pA0, pA1, K_lds);
        finishSM(pB0, pB1, alB, l_reg, pa0, pa1, pa2, pa3); SBAR();
        if (SD == 1 || j + 3 < NT) SLOAD(SE, j + 1 + SD); SBAR();
        pv_d0(o, vb0 + SHM_V, pa0, pa1, pa2, pa3); partialSM(pA0, pA1, m_reg, mnA, alA, C, thr_raw);
        __syncthreads(); SWAIT(); SWRITE(1, SO);
        RESC(alA); __syncthreads();
    }
    SBAR(); QKT(pB0, pB1, K_lds + SHM_K);
    finishSM(pA0, pA1, alA, l_reg, pa0, pa1, pa2, pa3); SBAR();
    pv_d0(o, vb0, pa0, pa1, pa2, pa3); partialSM(pB0, pB1, m_reg, mnB, alB, C, thr_raw);
    __syncthreads(); RESC(alB);
    finishSM(pB0, pB1, alB, l_reg, pa0, pa1, pa2, pa3); SBAR();
    pv_d0(o, vb0 + SHM_V, pa0, pa1, pa2, pa3);
    if (hi == 0) li_l[r32] = l_reg; asm volatile("s_waitcnt lgkmcnt(0)" ::: "memory");
    float rli[16];
#pragma unroll
    for (int r = 0; r < 16; ++r) rli[r] = __builtin_amdgcn_rcpf(li_l[crow(r, hi)]);
    bf16_t* Ow = Ob + (size_t)(qrow0 + wid * QBLK) * ldo;
#pragma unroll
    for (int r = 0; r < 16; ++r) { const int orow = crow(r, hi);
#pragma unroll
        for (int d0 = 0; d0 < 4; ++d0) Ow[(size_t)orow * ldo + d0 * 32 + r32] = (bf16_t)f2bf(o[d0][r] * rli[r]); }
    __syncthreads();
#undef KROW0
#undef SLOAD
#undef SWRITE
#undef SWAIT
#undef RESC
#undef QKT
}

template <int DQK>
DI void attn_unit_dma(const bf16_t* __restrict__ Qb, int ldq, const bf16_t* __restrict__ Kb, int ldk, const bf16_t* __restrict__ Vb, int ldv, bf16_t* __restrict__ Ob, int ldo,
                      int qrow0, int lat0, int nlat, int ctx0, int NT, float scale, char* lds, int tid, const float* __restrict__ rope = nullptr) {
    using G = Geo<DQK>;
    constexpr int SHM_K = G::SHM_K, KCH = G::KCH, NCH = G::NCH, ND0 = G::ND0;
    const float C = scale * 1.4426950408889634f;
    const int wid = __builtin_amdgcn_readfirstlane(tid >> 6), lane = tid & 63, r32 = lane & 31, hi = lane >> 5;
    char* V_lds = lds; char* K_lds = lds + 2 * SHM_V;
    float* wsf = (float*)(lds + 2 * SHM_V + 2 * SHM_K) + wid * 64; float* li_l = wsf; float* al_l = wsf + 32;
    float m_reg = -1e30f, l_reg = 0; f32x16 o[4] = {}; bf16x8 qr[ND0];
    const bf16_t* Qw = Qb + (size_t)(qrow0 + wid * QBLK + r32) * ldq + hi * 8;
#pragma unroll
    for (int d0 = 0; d0 < ND0; ++d0) qr[d0] = *(const bf16x8*)(Qw + d0 * 16);
    if constexpr (DQK == 192) {
        if (rope != nullptr && nlat > 0) {
            const int sq = (qrow0 + wid * QBLK + r32) & (SEQ - 1);
#pragma unroll
            for (int hf = 0; hf < 2; ++hf) { const int pos = hf ? (sq & (GRIDW - 1)) : (sq >> 6);
                const float* cs = rope + (pos * 16 + hi * 8) * 2;
                bf16x8 x1 = qr[8 + 2 * hf], x2 = qr[9 + 2 * hf];
#pragma unroll
                for (int e = 0; e < 8; ++e) { const float a = __builtin_bit_cast(float, (unsigned)(unsigned short)x1[e] << 16), bb = __builtin_bit_cast(float, (unsigned)(unsigned short)x2[e] << 16);
                    const float co = cs[2 * e], si = cs[2 * e + 1];
                    x1[e] = (short)f2bf(a * co - bb * si); x2[e] = (short)f2bf(bb * co + a * si); }
                qr[8 + 2 * hf] = x1; qr[9 + 2 * hf] = x2; }
        }
    }
    int koff[KCH], voff[2];
#pragma unroll
    for (int i = 0; i < KCH; ++i) { const int p = tid + 512 * i, row = p / NCH, cp = p % NCH; koff[i] = row * ldk + ((cp ^ (row & 7)) << 3); }
#pragma unroll
    for (int i = 0; i < 2; ++i) { const int p = tid + 512 * i, st = p >> 5, rem = p & 31, kk = ((st >> 2) << 3) | (rem >> 2);
        const int k = (kk & ~0xC) | ((kk & 4) << 1) | ((kk & 8) >> 1); voff[i] = k * ldv + (st & 3) * 32 + (rem & 3) * 8; }
    const int vb0 = (int)(uintptr_t)V_lds + v_rd_base(lane);
    const LAS unsigned char* const ldsl = (const LAS unsigned char*)lds;
#define KROW0(kt) ((kt) < nlat ? lat0 + (kt) * KVBLK : ctx0 + ((kt) - nlat) * KVBLK)
#define DMA_TILE(kt, b) do { const int _k0 = KROW0(kt); const bf16_t* _kp = Kb + (size_t)_k0 * ldk; const bf16_t* _vp = Vb + (size_t)_k0 * ldv; \
    _Pragma("unroll") for (int _c = 0; _c < KCH; ++_c) __builtin_amdgcn_global_load_lds((const unsigned*)(_kp + koff[_c]), (LAS unsigned*)(ldsl + 2 * SHM_V + (b) * SHM_K + _c * 8192 + wid * 1024), 16, 0, 0); \
    _Pragma("unroll") for (int _c = 0; _c < 2; ++_c) __builtin_amdgcn_global_load_lds((const unsigned*)(_vp + voff[_c]), (LAS unsigned*)(ldsl + (b) * SHM_V + _c * 8192 + wid * 1024), 16, 0, 0); } while (0)
    DMA_TILE(0, 0);
    asm volatile("s_waitcnt vmcnt(0)" ::: "memory"); __syncthreads();
#pragma unroll 1
    for (int j = 0; j < NT; ++j) {
        const int bsel = j & 1; const char* Ks = K_lds + bsel * SHM_K;
        if (j + 1 < NT) DMA_TILE(j + 1, bsel ^ 1);
        f32x16 p0 = {}, p1 = {};
#pragma unroll
        for (int d0 = 0; d0 < ND0; ++d0) { const int cb = (d0 * 16 + hi * 8) * 2;
            const bf16x8 b0 = *(const bf16x8*)(Ks + kswz<DQK>(r32, cb)); const bf16x8 b1 = *(const bf16x8*)(Ks + kswz<DQK>(32 + r32, cb));
            p0 = __builtin_amdgcn_mfma_f32_32x32x16_bf16(b0, qr[d0], p0, 0, 0, 0); p1 = __builtin_amdgcn_mfma_f32_32x32x16_bf16(b1, qr[d0], p1, 0, 0, 0); }
        float mn, alpha; bf16x8 pa0, pa1, pa2, pa3;
        partialSM(p0, p1, m_reg, mn, alpha, C, 0.f);
        if (__any(alpha < 1.f)) { if (hi == 0) al_l[r32] = alpha; asm volatile("s_waitcnt lgkmcnt(0)" ::: "memory");
#pragma unroll
            for (int d = 0; d < 4; ++d)
#pragma unroll
                for (int r = 0; r < 16; ++r) o[d][r] *= al_l[crow(r, hi)]; }
        finishSM(p0, p1, alpha, l_reg, pa0, pa1, pa2, pa3); SBAR();
        pv_d0(o, vb0 + bsel * SHM_V, pa0, pa1, pa2, pa3);
        asm volatile("s_waitcnt vmcnt(0)" ::: "memory");
        __syncthreads();
    }
    if (hi == 0) li_l[r32] = l_reg; asm volatile("s_waitcnt lgkmcnt(0)" ::: "memory");
    float rli[16];
#pragma unroll
    for (int r = 0; r < 16; ++r) rli[r] = __builtin_amdgcn_rcpf(li_l[crow(r, hi)]);
    bf16_t* Ow = Ob + (size_t)(qrow0 + wid * QBLK) * ldo;
#pragma unroll
    for (int r = 0; r < 16; ++r) { const int orow = crow(r, hi);
#pragma unroll
        for (int d0 = 0; d0 < 4; ++d0) Ow[(size_t)orow * ldo + d0 * 32 + r32] = (bf16_t)f2bf(o[d0][r] * rli[r]); }
    asm volatile("s_waitcnt vmcnt(0)" ::: "memory"); __syncthreads();
#undef KROW0
#undef DMA_TILE
}

template <int DQK>
DI void attn_unit_pd(const bf16_t* __restrict__ Qb, int ldq, const bf16_t* __restrict__ Kb, int ldk, const bf16_t* __restrict__ Vb, int ldv, bf16_t* __restrict__ Ob, int ldo,
                     int qrow0, int lat0, int nlat, int ctx0, int NT, float scale, char* lds, int tid, const float* __restrict__ rope = nullptr) {
    using G = Geo<DQK>;
    constexpr int SHM_K = G::SHM_K, KCH = G::KCH, NCH = G::NCH, ND0 = G::ND0, TILE = SHM_V + SHM_K;
    const float C = scale * 1.4426950408889634f, thr_raw = THR / scale;
    const int wid = __builtin_amdgcn_readfirstlane(tid >> 6), lane = tid & 63, r32 = lane & 31, hi = lane >> 5;
    float* wsf = (float*)(lds + 3 * TILE) + wid * 64; float* li_l = wsf; float* al_l = wsf + 32;
    float m_reg = -1e30f, l_reg = 0; f32x16 o[4] = {}; bf16x8 qr[ND0];
    const bf16_t* Qw = Qb + (size_t)(qrow0 + wid * QBLK + r32) * ldq + hi * 8;
#pragma unroll
    for (int d0 = 0; d0 < ND0; ++d0) qr[d0] = *(const bf16x8*)(Qw + d0 * 16);
    if constexpr (DQK == 192) {
        if (rope != nullptr && nlat > 0) {
            const int sq = (qrow0 + wid * QBLK + r32) & (SEQ - 1);
#pragma unroll
            for (int hf = 0; hf < 2; ++hf) { const int pos = hf ? (sq & (GRIDW - 1)) : (sq >> 6);
                const float* cs = rope + (pos * 16 + hi * 8) * 2;
                bf16x8 x1 = qr[8 + 2 * hf], x2 = qr[9 + 2 * hf];
#pragma unroll
                for (int e = 0; e < 8; ++e) { const float a = __builtin_bit_cast(float, (unsigned)(unsigned short)x1[e] << 16), bb = __builtin_bit_cast(float, (unsigned)(unsigned short)x2[e] << 16);
                    const float co = cs[2 * e], si = cs[2 * e + 1];
                    x1[e] = (short)f2bf(a * co - bb * si); x2[e] = (short)f2bf(bb * co + a * si); }
                qr[8 + 2 * hf] = x1; qr[9 + 2 * hf] = x2; }
        }
    }
    int koff[KCH], voff[2];
#pragma unroll
    for (int i = 0; i < KCH; ++i) { const int p = tid + 512 * i, row = p / NCH, cp = p % NCH; koff[i] = row * ldk + ((cp ^ (row & 7)) << 3); }
#pragma unroll
    for (int i = 0; i < 2; ++i) { const int p = tid + 512 * i, st = p >> 5, rem = p & 31, kk = ((st >> 2) << 3) | (rem >> 2);
        const int k = (kk & ~0xC) | ((kk & 4) << 1) | ((kk & 8) >> 1); voff[i] = k * ldv + (st & 3) * 32 + (rem & 3) * 8; }
    const int vb0 = (int)(uintptr_t)lds + v_rd_base(lane);
    LAS unsigned char* const ldsl = (LAS unsigned char*)lds;
#define KROW0(kt) ((kt) < nlat ? lat0 + (kt) * KVBLK : ctx0 + ((kt) - nlat) * KVBLK)
#define PD_DMA(kt, bsel) do { const int _k0 = KROW0(kt); const bf16_t* _kp = Kb + (size_t)_k0 * ldk; const bf16_t* _vp = Vb + (size_t)_k0 * ldv; const int _bo = (bsel) * TILE; \
    _Pragma("unroll") for (int _c = 0; _c < KCH; ++_c) __builtin_amdgcn_global_load_lds((const unsigned*)(_kp + koff[_c]), (LAS unsigned*)(ldsl + _bo + SHM_V + _c * 8192 + wid * 1024), 16, 0, 0); \
    _Pragma("unroll") for (int _c = 0; _c < 2; ++_c) __builtin_amdgcn_global_load_lds((const unsigned*)(_vp + voff[_c]), (LAS unsigned*)(ldsl + _bo + _c * 8192 + wid * 1024), 16, 0, 0); } while (0)
#define PD_WAIT1() do { if constexpr (KCH == 1) asm volatile("s_waitcnt vmcnt(3)" ::: "memory"); else asm volatile("s_waitcnt vmcnt(5)" ::: "memory"); } while (0)
#define PD_WAIT2() do { if constexpr (KCH == 1) asm volatile("s_waitcnt vmcnt(6)" ::: "memory"); else asm volatile("s_waitcnt vmcnt(10)" ::: "memory"); } while (0)
#define PD_BAR() do { asm volatile("s_waitcnt lgkmcnt(0)" ::: "memory"); __builtin_amdgcn_s_barrier(); asm volatile("" ::: "memory"); } while (0)
#define PD_RESC(a) do { if (__any((a) < 1.f)) { if (hi == 0) al_l[r32] = (a); asm volatile("s_waitcnt lgkmcnt(0)" ::: "memory"); \
    _Pragma("unroll") for (int d = 0; d < 4; ++d) _Pragma("unroll") for (int r = 0; r < 16; ++r) o[d][r] *= al_l[crow(r, hi)]; } } while (0)
#define PD_QKT(p0, p1, bsel) do { const char* Ks = lds + (bsel) * TILE + SHM_V; p0 = f32x16{}; p1 = f32x16{}; _Pragma("unroll") for (int d0 = 0; d0 < ND0; ++d0) { const int cb = (d0 * 16 + hi * 8) * 2; \
    const bf16x8 b0 = *(const bf16x8*)(Ks + kswz<DQK>(r32, cb)); const bf16x8 b1 = *(const bf16x8*)(Ks + kswz<DQK>(32 + r32, cb)); \
    p0 = __builtin_amdgcn_mfma_f32_32x32x16_bf16(b0, qr[d0], p0, 0, 0, 0); p1 = __builtin_amdgcn_mfma_f32_32x32x16_bf16(b1, qr[d0], p1, 0, 0, 0); } } while (0)
    f32x16 pA0, pA1, pB0, pB1; float mnA, mnB, alA, alB; bf16x8 pa0, pa1, pa2, pa3;
    PD_DMA(0, 0); PD_DMA(1, 1); PD_DMA(2, 2);
    PD_WAIT2(); PD_BAR();
    PD_QKT(pA0, pA1, 0); partialSM(pA0, pA1, m_reg, mnA, alA, C, thr_raw);
    PD_WAIT1(); PD_BAR();
    int b0i = 0, b1i = 1, b2i = 2;
#pragma unroll 1
    for (int j = 1; j + 1 < NT; j += 2) {
        SBAR(); PD_QKT(pB0, pB1, b1i);
        finishSM(pA0, pA1, alA, l_reg, pa0, pa1, pa2, pa3); SBAR();
        pv_d0(o, vb0 + b0i * TILE, pa0, pa1, pa2, pa3); partialSM(pB0, pB1, m_reg, mnB, alB, C, thr_raw);
        PD_BAR();
        if (j + 2 < NT) PD_DMA(j + 2, b0i);
        PD_RESC(alB);
        if (j + 2 < NT) PD_WAIT1(); else asm volatile("s_waitcnt vmcnt(0)" ::: "memory");
        PD_BAR();
        SBAR(); PD_QKT(pA0, pA1, b2i);
        finishSM(pB0, pB1, alB, l_reg, pa0, pa1, pa2, pa3); SBAR();
        pv_d0(o, vb0 + b1i * TILE, pa0, pa1, pa2, pa3); partialSM(pA0, pA1, m_reg, mnA, alA, C, thr_raw);
        PD_BAR();
        if (j + 3 < NT) PD_DMA(j + 3, b1i);
        PD_RESC(alA);
        if (j + 3 < NT) PD_WAIT1(); else asm volatile("s_waitcnt vmcnt(0)" ::: "memory");
        PD_BAR();
        { const int t0 = b0i; b0i = b2i; b2i = b1i; b1i = t0; }
    }
    SBAR(); PD_QKT(pB0, pB1, b1i);
    finishSM(pA0, pA1, alA, l_reg, pa0, pa1, pa2, pa3); SBAR();
    pv_d0(o, vb0 + b0i * TILE, pa0, pa1, pa2, pa3); partialSM(pB0, pB1, m_reg, mnB, alB, C, thr_raw);
    PD_RESC(alB);
    finishSM(pB0, pB1, alB, l_reg, pa0, pa1, pa2, pa3); SBAR();
    pv_d0(o, vb0 + b1i * TILE, pa0, pa1, pa2, pa3);
    if (hi == 0) li_l[r32] = l_reg; asm volatile("s_waitcnt lgkmcnt(0)" ::: "memory");
    float rli[16];
#pragma unroll
    for (int r = 0; r < 16; ++r) rli[r] = __builtin_amdgcn_rcpf(li_l[crow(r, hi)]);
    bf16_t* Ow = Ob + (size_t)(qrow0 + wid * QBLK) * ldo;
#pragma unroll
    for (int r = 0; r < 16; ++r) { const int orow = crow(r, hi);
#pragma unroll
        for (int d0 = 0; d0 < 4; ++d0) Ow[(size_t)orow * ldo + d0 * 32 + r32] = (bf16_t)f2bf(o[d0][r] * rli[r]); }
    PD_BAR();
#undef KROW0
#undef PD_DMA
#undef PD_WAIT1
#undef PD_WAIT2
#undef PD_BAR
#undef PD_RESC
#undef PD_QKT
}
}
namespace na {
constexpr int TILE_B = 16384;
constexpr int NBUF = 6, PFD = NBUF - 1  , BIAS_OFF = NBUF * TILE_B, BIAS_ROWS = 23, BIAS_B = BIAS_ROWS * 64 * 4, WS_OFF = BIAS_OFF + BIAS_B, LDS_NEED = WS_OFF + 8 * 256;
DI int kswz64(int row, int colB) { return row * 128 + (colB ^ ((row & 7) << 4)); }
template <int OFF> DI s16x4 trr(int vb) { s16x4 r; asm volatile("ds_read_b64_tr_b16 %0, %1 offset:%2" : "=&v"(r) : "v"(vb), "i"(OFF) : "memory"); return r; }
DI bf16x8 pk4(const f32x16& P, int base) {
    unsigned a0, a1, b0, b1;
    if (base == 0) { a0 = cvt_pk_bf16(P[0], P[1]); a1 = cvt_pk_bf16(P[2], P[3]); b0 = cvt_pk_bf16(P[4], P[5]); b1 = cvt_pk_bf16(P[6], P[7]); }
    else { a0 = cvt_pk_bf16(P[8], P[9]); a1 = cvt_pk_bf16(P[10], P[11]); b0 = cvt_pk_bf16(P[12], P[13]); b1 = cvt_pk_bf16(P[14], P[15]); }
    auto r0 = __builtin_amdgcn_permlane32_swap(a0, b0, false, false); auto r1 = __builtin_amdgcn_permlane32_swap(a1, b1, false, false);
    u32x4 w = {r0[0], r1[0], r0[1], r1[1]}; return __builtin_bit_cast(bf16x8, w);
}
#define NA_PK(L, H) (bf16x8){L[0], L[1], L[2], L[3], H[0], H[1], H[2], H[3]}
template <int S> DI void pv_step(f32x16 (&o)[2], int vb, bf16x8 pa) {
    const s16x4 l0 = trr<S * 2048>(vb), h0 = trr<S * 2048 + 1024>(vb), l1 = trr<S * 2048 + 512>(vb), h1 = trr<S * 2048 + 1024 + 512>(vb);
    asm volatile("s_waitcnt lgkmcnt(0)" ::: "memory"); __builtin_amdgcn_sched_barrier(0);
    o[0] = __builtin_amdgcn_mfma_f32_32x32x16_bf16(pa, NA_PK(l0, h0), o[0], 0, 0, 0);
    o[1] = __builtin_amdgcn_mfma_f32_32x32x16_bf16(pa, NA_PK(l1, h1), o[1], 0, 0, 0);
}

DI void na_unit(const bf16_t* __restrict__ QKV, const float* __restrict__ rpb, bf16_t* __restrict__ NAO, int unit, char* lds, int tid, bool build_table) {
    const int rg = unit & 7, h = (unit >> 3) & 15, b = unit >> 7;
    const int wid = __builtin_amdgcn_readfirstlane(tid >> 6), lane = tid & 63, r32 = lane & 31, hi = lane >> 5;
    const int r0 = rg * 4, rp = wid >> 2, n = wid & 3;
    const int rq = r0 + 2 * rp + (r32 >> 4), cq = 16 * n + (r32 & 15);
    const int cb = min(max(16 * n - 8, 0), 32), qs = min(max(cq - 8, 0), 48), rsq = min(max(rq - 4, 0), 24);
    const int kr_lo = min(max(r0 - 4, 0), 24), kr_hi = min(max(r0 - 1, 0), 24) + 7, nloc = kr_hi - kr_lo + 1, NT = nloc + 4;
    const int wlo = min(max(r0 + 2 * rp - 4, 0), 24), whi = min(max(r0 + 2 * rp - 3, 0), 24) + 7;
    LAS unsigned char* const ldsl = (LAS unsigned char*)lds;
    LAS float* const btab = (LAS float*)(ldsl + BIAS_OFF);
    float* wsf = (float*)(lds + WS_OFF) + wid * 64; float* li_l = wsf; float* al_l = wsf + 32;
    constexpr float L2E = 1.4426950408889634f, SC = 0.125f * L2E;
    if (build_table) { for (int i = tid; i < BIAS_ROWS * 64; i += NTHREADS) { const int dr = (i >> 6) - 4, idx = (i & 63) - 16;
        btab[i] = (dr >= 0 && dr < 15 && idx >= 0 && idx < 31) ? rpb[h * (15 * 31) + dr * 31 + idx] * L2E : 0.f; } }
    const size_t tq = (size_t)b * SEQ + rq * GRIDW + cq;
    bf16x8 qr[4];
#pragma unroll
    for (int d0 = 0; d0 < 4; ++d0) qr[d0] = *(const bf16x8*)(QKV + tq * 3072 + h * 64 + d0 * 16 + hi * 8);
    unsigned vmask = 0;
#pragma unroll
    for (int r = 0; r < 16; ++r) { const int kc = cb + att::crow(r, hi); vmask |= (kc >= qs && kc < qs + 16) ? (1u << r) : 0u; }
    const int blane = (7 + 4 - rq) * 64 + (cb + 4 * hi - cq + 15 + 16);
    const int krow_ = tid >> 3, koff = krow_ * 3072 + 1024 + h * 64 + (((tid & 7) ^ (krow_ & 7)) << 3);
    const int vst = tid >> 5, vrem = tid & 31, vkk = ((vst >> 1) << 3) | (vrem >> 2), vk = (vkk & ~0xC) | ((vkk & 4) << 1) | ((vkk & 8) >> 1);
    const int voff = vk * 3072 + 2048 + h * 64 + (vst & 1) * 32 + (vrem & 3) * 8;
    const int g8 = (cb >> 3) + hi, vba = (2 * (g8 >> 1)) * 1024 + (4 * (g8 & 1)) * 64 + (((lane >> 2) & 3) << 6) + ((lane & 3) << 3) + (((lane >> 4) & 1) << 5);
    const int lbase = (int)(uintptr_t)lds;
#define NA_TOK0(j) ((j) < nloc ? (size_t)b * SEQ + (size_t)(kr_lo + (j)) * GRIDW : (size_t)TL + (size_t)b * CTXL + (size_t)((j) - nloc) * 64)
#define NA_DMA(j) do { const bf16_t* _src = QKV + NA_TOK0(j) * 3072; const int _bo = ((j) % NBUF) * TILE_B; \
    __builtin_amdgcn_global_load_lds((const unsigned*)(_src + koff), (LAS unsigned*)(ldsl + _bo + wid * 1024), 16, 0, 0); \
    __builtin_amdgcn_global_load_lds((const unsigned*)(_src + voff), (LAS unsigned*)(ldsl + _bo + 8192 + wid * 1024), 16, 0, 0); } while (0)
    float m_reg = -1e28f, l_reg = 0.f; f32x16 o[2] = {};
    __syncthreads();
    NA_DMA(0); NA_DMA(1); NA_DMA(2); NA_DMA(3); NA_DMA(4);
    asm volatile("s_waitcnt vmcnt(8) lgkmcnt(0)" ::: "memory"); __builtin_amdgcn_s_barrier(); asm volatile("" ::: "memory");
#define NA_TILE_POST(j) do { const int _rem = min(NT - 1, (j) + PFD) - ((j) + 1);     \
        if (_rem >= 4) asm volatile("s_waitcnt vmcnt(8)" ::: "memory"); else if (_rem == 3) asm volatile("s_waitcnt vmcnt(6)" ::: "memory"); else if (_rem == 2) asm volatile("s_waitcnt vmcnt(4)" ::: "memory"); \
        else if (_rem == 1) asm volatile("s_waitcnt vmcnt(2)" ::: "memory"); else asm volatile("s_waitcnt vmcnt(0)" ::: "memory"); \
        asm volatile("s_waitcnt lgkmcnt(0)" ::: "memory"); __builtin_amdgcn_s_barrier(); asm volatile("" ::: "memory"); } while (0)
    int j = 0;
#pragma unroll 1
    for (; j < nloc; ++j) {
        if (j + PFD < NT) NA_DMA(j + PFD);
        const int bo = (j % NBUF) * TILE_B; const char* Ks = lds + bo;
        const int kr = kr_lo + j;
        {
            if (kr >= wlo && kr <= whi) {
                f32x16 p0 = {};
#pragma unroll
                for (int d0 = 0; d0 < 4; ++d0) { const bf16x8 kf = *(const bf16x8*)(Ks + kswz64(cb + r32, (d0 * 16 + hi * 8) * 2)); p0 = __builtin_amdgcn_mfma_f32_32x32x16_bf16(kf, qr[d0], p0, 0, 0, 0); }
                const unsigned mk = ((unsigned)(kr - rsq) < 8u) ? vmask : 0u;
                const LAS float* bp = btab + (blane + kr * 64);
                float pmax = -1e30f;
#pragma unroll
                for (int r = 0; r < 16; ++r) { const float bias = bp[att::crow(r, 0)];
                    float v = fmaf(p0[r], SC, bias); v = ((mk >> r) & 1u) ? v : -1e30f; p0[r] = v; pmax = fmaxf(pmax, v); }
                { auto rr = __builtin_amdgcn_permlane32_swap(__float_as_uint(pmax), __float_as_uint(pmax), false, false); pmax = fmaxf(__uint_as_float(rr[0]), __uint_as_float(rr[1])); }
                const float mn = fmaxf(m_reg, pmax), alpha = __builtin_amdgcn_exp2f(m_reg - mn); m_reg = mn;
                float ps = 0.f;
#pragma unroll
                for (int r = 0; r < 16; ++r) { p0[r] = __builtin_amdgcn_exp2f(p0[r] - mn); ps += p0[r]; }
                { auto rr = __builtin_amdgcn_permlane32_swap(__float_as_uint(ps), __float_as_uint(ps), false, false); ps = __uint_as_float(rr[0]) + __uint_as_float(rr[1]); }
                l_reg = l_reg * alpha + ps;
                if (__any(alpha < 1.f)) { if (hi == 0) al_l[r32] = alpha; asm volatile("s_waitcnt lgkmcnt(0)" ::: "memory");
#pragma unroll
                    for (int d = 0; d < 2; ++d)
#pragma unroll
                        for (int r = 0; r < 16; ++r) o[d][r] *= al_l[att::crow(r, hi)]; }
                const bf16x8 pa0 = pk4(p0, 0), pa1 = pk4(p0, 8);
                __builtin_amdgcn_sched_barrier(0);
                const int vb = lbase + bo + 8192 + vba;
                pv_step<0>(o, vb, pa0); pv_step<1>(o, vb, pa1);
            }
        }
        NA_TILE_POST(j);
    }
#pragma unroll 1
    for (; j < NT; ++j) {
        if (j + PFD < NT) NA_DMA(j + PFD);
        const int bo = (j % NBUF) * TILE_B; const char* Ks = lds + bo;
        {
            f32x16 p0 = {}, p1 = {};
#pragma unroll
            for (int d0 = 0; d0 < 4; ++d0) { const int cbb = (d0 * 16 + hi * 8) * 2;
                const bf16x8 k0 = *(const bf16x8*)(Ks + kswz64(r32, cbb)), k1 = *(const bf16x8*)(Ks + kswz64(32 + r32, cbb));
                p0 = __builtin_amdgcn_mfma_f32_32x32x16_bf16(k0, qr[d0], p0, 0, 0, 0); p1 = __builtin_amdgcn_mfma_f32_32x32x16_bf16(k1, qr[d0], p1, 0, 0, 0); }
            float pmax = -1e30f;
#pragma unroll
            for (int r = 0; r < 16; ++r) { p0[r] *= SC; p1[r] *= SC; pmax = fmaxf(pmax, fmaxf(p0[r], p1[r])); }
            { auto rr = __builtin_amdgcn_permlane32_swap(__float_as_uint(pmax), __float_as_uint(pmax), false, false); pmax = fmaxf(__uint_as_float(rr[0]), __uint_as_float(rr[1])); }
            const float mn = fmaxf(m_reg, pmax), alpha = __builtin_amdgcn_exp2f(m_reg - mn); m_reg = mn;
            float ps = 0.f;
#pragma unroll
            for (int r = 0; r < 16; ++r) { p0[r] = __builtin_amdgcn_exp2f(p0[r] - mn); p1[r] = __builtin_amdgcn_exp2f(p1[r] - mn); ps += p0[r] + p1[r]; }
            { auto rr = __builtin_amdgcn_permlane32_swap(__float_as_uint(ps), __float_as_uint(ps), false, false); ps = __uint_as_float(rr[0]) + __uint_as_float(rr[1]); }
            l_reg = l_reg * alpha + ps;
            if (__any(alpha < 1.f)) { if (hi == 0) al_l[r32] = alpha; asm volatile("s_waitcnt lgkmcnt(0)" ::: "memory");
#pragma unroll
                for (int d = 0; d < 2; ++d)
#pragma unroll
                    for (int r = 0; r < 16; ++r) o[d][r] *= al_l[att::crow(r, hi)]; }
            const bf16x8 pa0 = pk4(p0, 0), pa1 = pk4(p0, 8), pa2 = pk4(p1, 0), pa3 = pk4(p1, 8);
            __builtin_amdgcn_sched_barrier(0);
            const int vb = lbase + bo + 8192 + hi * 256 + (((lane >> 2) & 3) << 6) + ((lane & 3) << 3) + (((lane >> 4) & 1) << 5);
            pv_step<0>(o, vb, pa0); pv_step<1>(o, vb, pa1); pv_step<2>(o, vb, pa2); pv_step<3>(o, vb, pa3);
        }
        NA_TILE_POST(j);
    }
#undef NA_TILE_POST
    if (hi == 0) li_l[r32] = l_reg; asm volatile("s_waitcnt lgkmcnt(0)" ::: "memory");
#pragma unroll
    for (int r = 0; r < 16; ++r) { const int qi = att::crow(r, hi); const float rl = __builtin_amdgcn_rcpf(li_l[qi]);
        const size_t tok = (size_t)b * SEQ + (size_t)(r0 + 2 * rp + (qi >> 4)) * GRIDW + 16 * n + (qi & 15);
        bf16_t* op = NAO + tok * 1024 + h * 64 + r32;
        op[0] = (bf16_t)f2bf(o[0][r] * rl); op[32] = (bf16_t)f2bf(o[1][r] * rl); }
#undef NA_TOK0
#undef NA_DMA
}
#undef NA_PK
}
DI void p_route_a(const Ctx& c, int l, int ntok) {
    const float* LG = c.r<float>(R_LG); float* TOPW = c.r<float>(R_TOPW); unsigned* EPOS = c.r<unsigned>(R_EPOS);
    LAS unsigned* lcnt = (LAS unsigned*)(c.lds + LDSCTL_OFF + 256); LAS unsigned* lbase = lcnt + 32;
    unsigned* gcnt = c.ctl() + CW_CNT + l * 32 * 64;
    if (c.tid < 64) lcnt[c.tid] = 0u;
    __syncthreads();
    const int per = (ntok + c.G - 1) / c.G, t0 = c.blk * per, t1 = min(t0 + per, ntok);
    const int e = c.lane & 31, half = c.lane >> 5;
    for (int p = t0 + 2 * c.wave; p < t1; p += 2 * NWAVES) {
        const int tok = p + half; const bool valid = tok < t1;
        float v = valid ? LG[(size_t)tok * 32 + e] : -3.0e38f;
        float tv[4]; int te[4];
#pragma unroll
        for (int k = 0; k < 4; ++k) {
            const float mx = half_max(v);
            const unsigned long long bal = __ballot(v == mx);
            const unsigned bits = (unsigned)(bal >> (32 * half));
            const int sel = __ffs(bits) - 1;
            tv[k] = mx; te[k] = sel;
            if (e == sel) v = -3.0e38f;
        }
        const float e1 = __expf(tv[1] - tv[0]), e2 = __expf(tv[2] - tv[0]), e3 = __expf(tv[3] - tv[0]);
        const float inv = 1.0f / (1.0f + e1 + e2 + e3);
        if (valid && e < 4) {
            const int ee = e == 0 ? te[0] : e == 1 ? te[1] : e == 2 ? te[2] : te[3];
            const float ww = (e == 0 ? 1.0f : e == 1 ? e1 : e == 2 ? e2 : e3) * inv;
            const unsigned lp = atomicAdd((unsigned*)&lcnt[ee], 1u);
            TOPW[(size_t)tok * 4 + e] = ww;
            EPOS[(size_t)tok * 4 + e] = ((unsigned)ee << 24) | lp;
        }
    }
    __syncthreads();
    if (c.tid < 32) lbase[c.tid] = __hip_atomic_fetch_add(gcnt + 64 * c.tid, lcnt[c.tid], __ATOMIC_RELAXED, __HIP_MEMORY_SCOPE_AGENT);
    __syncthreads();
}
DI void p_route_b(const Ctx& c, int l, int ntok) {
    const unsigned* EPOS = c.r<unsigned>(R_EPOS); unsigned* SLOT = c.r<unsigned>(R_SLOT); unsigned* ROWTOK = c.r<unsigned>(R_ROWTOK);
    LAS unsigned* lcnt = (LAS unsigned*)(c.lds + LDSCTL_OFF + 256); LAS unsigned* lbase = lcnt + 32; LAS unsigned* cnt = lcnt + 64; LAS unsigned* tstart = lcnt + 96;
    unsigned* gcnt = c.ctl() + CW_CNT + l * 32 * 64;
    if (c.tid < 32) cnt[c.tid] = __hip_atomic_load(gcnt + 64 * c.tid, __ATOMIC_RELAXED, __HIP_MEMORY_SCOPE_AGENT);
    __syncthreads();
    if (c.tid == 0) { unsigned s = 0; for (int e = 0; e < 32; ++e) { tstart[e] = s; s += (cnt[e] + 255u) >> 8; } tstart[32] = s; }
    __syncthreads();
    const int per = (ntok + c.G - 1) / c.G, t0 = c.blk * per, t1 = min(t0 + per, ntok);
    for (int i = 4 * t0 + c.tid; i < 4 * t1; i += NTHREADS) {
        const unsigned ep = EPOS[i], e = ep >> 24, lp = ep & 0xffffffu;
        const unsigned dest = tstart[e] * 256u + lbase[e] + lp;
        ROWTOK[dest] = (unsigned)(i >> 2); SLOT[i] = dest;
    }
    unsigned* mw = c.misc();
    if (c.blk < 32) {
        const unsigned e = c.blk, ts = tstart[e], te = tstart[e + 1], n = cnt[e];
        for (unsigned i = n + c.tid; i < (te - ts) * 256u; i += NTHREADS) ROWTOK[ts * 256u + i] = 0u;
        for (unsigned t = ts + c.tid; t < te; t += NTHREADS) ((int*)mw)[MW_TILEE + l * 2048 + t] = (int)e;
    }
    if (c.blk == 0 && c.tid == 0) mw[MW_NT + l] = tstart[32];
    __syncthreads();
}

DI void p_postmix_route(const Ctx& c, int l, int ntok) {
    const bf16_t* Y = c.r<bf16_t>(R_Y); float* TOPW = c.r<float>(R_TOPW); unsigned* EPOS = c.r<unsigned>(R_EPOS);
    LAS unsigned* lcnt = (LAS unsigned*)(c.lds + LDSCTL_OFF + 256); LAS unsigned* lbase = lcnt + 32;
    unsigned* gcnt = c.ctl() + CW_CNT + l * 32 * 64;
    LAS u32x4* bfr = (LAS u32x4*)c.lds;
    LAS unsigned char* stg = c.lds + 65536 + c.wave * 4096;
    if (c.tid < 64) lcnt[c.tid] = 0u;
    { const float* rw = c.in(I_RW) + (size_t)l * 1024 * 32;
      for (int i = c.tid; i < 32 * 2 * 64; i += NTHREADS) { const int s = i >> 7, nb = (i >> 6) & 1, ln = i & 63, e = (ln & 15) + 16 * nb, k0 = 32 * s + 8 * (ln >> 4);
          u32x4 w; w.x = pk2(rw[(k0 + 0) * 32 + e], rw[(k0 + 1) * 32 + e]); w.y = pk2(rw[(k0 + 2) * 32 + e], rw[(k0 + 3) * 32 + e]);
          w.z = pk2(rw[(k0 + 4) * 32 + e], rw[(k0 + 5) * 32 + e]); w.w = pk2(rw[(k0 + 6) * 32 + e], rw[(k0 + 7) * 32 + e]); bfr[i] = w; } }
    const int per = (ntok + c.G - 1) / c.G, t0 = c.blk * per, t1 = min(t0 + per, ntok);
    LAS float* Pm = (LAS float*)(c.lds + 98304);
    const int b0 = mod_idx(min(t0, ntok - 1)), b1 = mod_idx(max(min(t1, ntok) - 1, 0));
    { const float* g0 = c.in(I_MIXPOST) + l * DM; const float* g1 = c.in(I_FFNPRE) + l * DM; const float* m0 = c.mod(l, b0) + 2048; const float* m1 = c.mod(l, b1) + 2048;
      for (int i = c.tid; i < 1024; i += NTHREADS) { Pm[i] = g0[i]; Pm[1024 + i] = g1[i];
          Pm[2048 + i] = m0[i]; Pm[3072 + i] = m0[1024 + i]; Pm[4096 + i] = m0[2048 + i]; Pm[5120 + i] = m1[i]; Pm[6144 + i] = m1[1024 + i]; Pm[7168 + i] = m1[2048 + i]; } }
    __syncthreads();
    const int lane = c.lane, e = lane & 31, half = lane >> 5;
    const float rbias = c.in(I_RB)[l * 32 + e];
    u32x2 yrA[4], yrB[4], nyA[4], nyB[4]; f32x4 xA[4], xB[4], nxA[4], nxB[4];
    auto ldrows = [&](int mq, u32x2 (&ya)[4], f32x4 (&xa)[4], u32x2 (&yb)[4], f32x4 (&xb)[4]) {
        const int a = min(mq, t1 - 1), b = min(mq + 1, t1 - 1);
#pragma unroll
        for (int j = 0; j < 4; ++j) { ya[j] = ((const u32x2*)(Y + (size_t)a * DM))[lane + 64 * j]; yb[j] = ((const u32x2*)(Y + (size_t)b * DM))[lane + 64 * j]; }
        if (l == 0) { load_row_f32(xin_row(c, a), lane, xa); load_row_f32(xin_row(c, b), lane, xb); } else { load_row_f32(xrow(c, a), lane, xa); load_row_f32(xrow(c, b), lane, xb); }
    };
    int mA = t0 + 2 * c.wave;
    if (mA < t1) ldrows(mA, nyA, nxA, nyB, nxB);
#pragma unroll 1
    for (; mA < t1; mA += 2 * NWAVES) {
        const int mB = mA + 1; const bool okB = mB < t1;
        f32x4 yA[4], yB[4];
#pragma unroll
        for (int j = 0; j < 4; ++j) { yrA[j] = nyA[j]; yrB[j] = nyB[j]; xA[j] = nxA[j]; xB[j] = nxB[j]; }
        if (mA + 2 * NWAVES < t1) ldrows(mA + 2 * NWAVES, nyA, nxA, nyB, nxB);
#pragma unroll
        for (int j = 0; j < 4; ++j) { yA[j] = (f32x4){bflo(yrA[j].x), bfhi(yrA[j].x), bflo(yrA[j].y), bfhi(yrA[j].y)}; yB[j] = (f32x4){bflo(yrB[j].x), bfhi(yrB[j].x), bflo(yrB[j].y), bfhi(yrB[j].y)}; }
#pragma unroll
        for (int r = 0; r < 2; ++r) {
            if (r == 1 && !okB) break;
            const int m = r ? mB : mA; f32x4 (&y)[4] = r ? yB : yA; f32x4 (&x)[4] = r ? xB : xA;
            const LAS float* ms = Pm + 2048 + (mod_idx(m) == b0 ? 0 : 3072);
            f32x4 pg[4], pt[4];
#pragma unroll
            for (int j = 0; j < 4; ++j) { pg[j] = ((const LAS f32x4*)Pm)[lane + 64 * j]; pt[j] = ((const LAS f32x4*)ms)[lane + 64 * j]; }
            __builtin_amdgcn_sched_barrier(0);
            const float rstd = row_rstd(y);
#pragma unroll
            for (int j = 0; j < 4; ++j) x[j] = x[j] + pt[j] * (y[j] * rstd * pg[j]);
            float* xo = xrow(c, m);
#pragma unroll
            for (int j = 0; j < 4; ++j) ((f32x4*)xo)[lane + 64 * j] = x[j];
            f32x4 qg[4], qh[4], qc[4];
#pragma unroll
            for (int j = 0; j < 4; ++j) { qg[j] = ((const LAS f32x4*)(Pm + 1024))[lane + 64 * j]; qh[j] = ((const LAS f32x4*)(ms + 1024))[lane + 64 * j]; qc[j] = ((const LAS f32x4*)(ms + 2048))[lane + 64 * j]; }
            __builtin_amdgcn_sched_barrier(0);
            const float rs2 = row_rstd(x);
            unsigned* h8 = (unsigned*)(c.ws + WS_H8 + (size_t)m * DM);
#pragma unroll
            for (int j = 0; j < 4; ++j) {
                const f32x4 h = x[j] * rs2 * qg[j] * (qc[j] + 1.0f) + qh[j];
                h8[lane + 64 * j] = pk4_fp8(h[0], h[1], h[2], h[3]);
                u32x2 w; w.x = pk2(h[0], h[1]); w.y = pk2(h[2], h[3]); ((LAS u32x2*)(stg + r * 2048))[lane + 64 * j] = w; }
        }
        f32x4 acc0 = {0.f, 0.f, 0.f, 0.f}, acc1 = {0.f, 0.f, 0.f, 0.f};
        const LAS unsigned char* ap = stg + (lane & 1) * 2048 + (lane >> 4) * 16;
#pragma unroll 1
        for (int s0 = 0; s0 < 32; s0 += 4) {
            bf16x8 fa[4], fb0[4], fb1[4];
#pragma unroll
            for (int i = 0; i < 4; ++i) { const int s = s0 + i; fa[i] = *(const LAS bf16x8*)(ap + s * 64);
                fb0[i] = __builtin_bit_cast(bf16x8, bfr[(s * 2 + 0) * 64 + lane]); fb1[i] = __builtin_bit_cast(bf16x8, bfr[(s * 2 + 1) * 64 + lane]); }
            __builtin_amdgcn_sched_barrier(0);
#pragma unroll
            for (int i = 0; i < 4; ++i) { acc0 = __builtin_amdgcn_mfma_f32_16x16x32_bf16(fa[i], fb0[i], acc0, 0, 0, 0); acc1 = __builtin_amdgcn_mfma_f32_16x16x32_bf16(fa[i], fb1[i], acc1, 0, 0, 0); }
            __builtin_amdgcn_sched_barrier(0);
        }
        const int src = lane & 15;
        const float a0 = __shfl(acc0[0], src), a1 = __shfl(acc1[0], src), b0v = __shfl(acc0[1], src), b1v = __shfl(acc1[1], src);
        const int tok = mA + half; const bool valid = tok < t1;
        float v = (half == 0 ? ((lane & 16) ? a1 : a0) : ((lane & 16) ? b1v : b0v)) + rbias;
        if (!valid) v = -3.0e38f;
        float tv[4]; int te[4];
#pragma unroll
        for (int k = 0; k < 4; ++k) {
            const float mx = half_max(v);
            const unsigned long long bal = __ballot(v == mx);
            const unsigned bits = (unsigned)(bal >> (32 * half));
            const int sel = __ffs(bits) - 1;
            tv[k] = mx; te[k] = sel;
            if (e == sel) v = -3.0e38f;
        }
        const float e1 = __expf(tv[1] - tv[0]), e2 = __expf(tv[2] - tv[0]), e3 = __expf(tv[3] - tv[0]);
        const float inv = 1.0f / (1.0f + e1 + e2 + e3);
        if (valid && e < 4) {
            const int ee = e == 0 ? te[0] : e == 1 ? te[1] : e == 2 ? te[2] : te[3];
            const float ww = (e == 0 ? 1.0f : e == 1 ? e1 : e == 2 ? e2 : e3) * inv;
            const unsigned lp = atomicAdd((unsigned*)&lcnt[ee], 1u);
            TOPW[(size_t)tok * 4 + e] = ww;
            EPOS[(size_t)tok * 4 + e] = ((unsigned)ee << 24) | lp;
        }
    }
    __syncthreads();
    if (c.tid < 32) lbase[c.tid] = __hip_atomic_fetch_add(gcnt + 64 * c.tid, lcnt[c.tid], __ATOMIC_RELAXED, __HIP_MEMORY_SCOPE_AGENT);
    __syncthreads();
}
__global__ void __launch_bounds__(NTHREADS, 2) fwd_kernel(Params prm) {
    extern __shared__ __attribute__((aligned(16))) unsigned char lds_raw[];
    LAS unsigned char* const ldsl = (LAS unsigned char*)lds_raw;
    for (int u = threadIdx.x; u < (LDS_BYTES - LDSCTL_OFF) / 4; u += NTHREADS) ((LAS unsigned*)(ldsl + LDSCTL_OFF))[u] = 0u;
    __syncthreads();
    { const Ctx c = mk_ctx(prm, ldsl); (void)xcd_barrier_post(c.ctl() + CW_BAR, (volatile LAS unsigned*)(ldsl + LDSCTL_OFF)); }
#define CTX() const Ctx c = mk_ctx(prm, ldsl); unsigned char* const ws = c.ws; char* const ldsg = (char*)lds_raw; (void)ws; (void)ldsg
#ifndef REPMASK
#define REPMASK 0
#endif
#ifndef PROBEFLAG
#define PROBEFLAG 0
#endif
#define PRB(bit) (((((REPMASK) >> (bit)) & 1) && _rp < 2) ? PROBEFLAG : 0)
#define RPL(bit) _Pragma("unroll 1") for (int _rp = 0; _rp < ((((REPMASK) >> (bit)) & 1) ? 3 : 1); ++_rp)
#define GRID_BAR() do { XcdBarrier _b; _b.bar = launder((unsigned*)prm.ws) + CW_BAR; _b.x = xb_xcc_id(); _b.st = (volatile LAS unsigned*)(ldsl + LDSCTL_OFF); xcd_barrier(_b); } while (0)

    { CTX(); p0a_tables(c); } GRID_BAR();
    RPL(0) { CTX(); p0b_weights(c); } GRID_BAR();
    RPL(6) { CTX(); p_prenorm0(c); } GRID_BAR();

#pragma unroll 1
    for (int l = 0; l < 2; ++l) {
        const bool last = (l == 1);
        const int ntok = last ? TL : TT;
        if (l == 0) {
            RPL(1) { CTX(); pg8::DenseProb8 P{ws + WS_H8, ws + WS_WIN, 1024, TT / 256, EVEN_IN_PAD / 256, c.G, c.blk};
              LAS float* ropel = (LAS float*)(c.lds + LDSCTL_OFF + 8192);
              { const f32x4* src = (const f32x4*)(ws + WS_ROPE); ((LAS f32x4*)ropel)[c.tid] = src[c.tid]; }
              __syncthreads();
              pg8::EpiInproj E{c.r<bf16_t>(R_P), EVEN_IN_PAD, ropel};
              pg8::gemm_phase<pg8::DenseProb8, pg8::EpiInproj, true>(c.lds, P, E, c.tid); }
            GRID_BAR();
            { CTX(); p_even_post_inproj(c); } GRID_BAR();
            RPL(1) { CTX(); pg8::DenseProb P{c.r<bf16_t>(R_CQN), (const bf16_t*)(ws + WS_WQB), 512, TT / 256, 3, c.G, c.blk};
              pg8::EpiBf16W E{c.r<bf16_t>(R_QM), 768, 256, 128};
              pg8::gemm_phase(c.lds, P, E, c.tid); }
            RPL(1) { CTX(); pg8::DenseProb P{c.r<bf16_t>(R_CKVN), (const bf16_t*)(ws + WS_WKVB), 256, TT / 256, 4, c.G, c.blk};
              pg8::EpiBf16 E{c.r<bf16_t>(R_KVX), 1280, 320, 192};
              pg8::gemm_phase(c.lds, P, E, c.tid); }
            GRID_BAR();
            RPL(2) { CTX();
                const bf16_t* QM = c.r<bf16_t>(R_QM); const bf16_t* KVX = c.r<bf16_t>(R_KVX); bf16_t* AOM = c.r<bf16_t>(R_AOM);
#pragma unroll 1
                for (int u = c.vcu; u < 1152; u += c.G) {
                    int b, h, qrow0, nlat, NT;
                    if (u < 1024) { const int qt = u & 7; h = (u >> 3) & 3; b = u >> 5; qrow0 = b * SEQ + qt * 256; nlat = 32; NT = 36; }
                    else { const int v = u - 1024; h = v & 3; b = v >> 2; qrow0 = TL + b * CTXL; nlat = 0; NT = 4; }
                    att::attn_unit_pd<192>(QM + h * 192, 768, KVX + h * 320, 1280, KVX + h * 320 + 192, 1280, AOM + 512 + h * 128, 1024, qrow0, b * SEQ, nlat, TL + b * CTXL, NT, 0.07216878364870322f, ldsg, c.tid, (const float*)(ws + WS_ROPE));
                }
            }
            RPL(7) { CTX();
                const bf16_t* Pb = c.r<bf16_t>(R_P); bf16_t* AO = c.r<bf16_t>(R_AO);
#pragma unroll 1
                for (int u = c.vcu; u < 2304; u += c.G) {
                    int b, j, qrow0, nlat, NT;
                    if (u < 2048) { const int qt = u & 7; j = (u >> 3) & 7; b = u >> 6; qrow0 = b * SEQ + qt * 256; nlat = 32; NT = 36; }
                    else { const int v = u - 2048; j = v & 7; b = v >> 3; qrow0 = TL + b * CTXL; nlat = 0; NT = 4; }
                    const int hd = j >> 1, mp = j & 1;
                    att::attn_unit_pd<64>(Pb + hd * 128 + mp * 64, EVEN_IN_PAD, Pb + 512 + hd * 128 + mp * 64, EVEN_IN_PAD, Pb + 1024 + hd * 128, EVEN_IN_PAD, AO + j * 128, 1024,
                                          qrow0, b * SEQ, nlat, TL + b * CTXL, NT, 0.125f, ldsg, c.tid);
                }
            }
            GRID_BAR();
            RPL(8) { CTX(); p_diff_merge(c); } GRID_BAR();
            RPL(1) { CTX(); pg8::DenseProb P{c.r<bf16_t>(R_AOM), (const bf16_t*)(ws + WS_WOUT), 2048, TT / 256, 4, c.G, c.blk};
              pg8::EpiBf16W E{c.r<bf16_t>(R_Y), 1024, 256, 128};
              pg8::gemm_phase(c.lds, P, E, c.tid); }
            GRID_BAR();
        } else {
            RPL(1) { CTX(); pg8::DenseProb8 P{ws + WS_H8, ws + WS_WQKV, 1024, TT / 256, 12, c.G, c.blk};
              pg8::EpiBf16W E{c.r<bf16_t>(R_QKV), 3072, 256, 128};
              pg8::gemm_phase<pg8::DenseProb8, pg8::EpiBf16W, true>(c.lds, P, E, c.tid); }
            GRID_BAR();
            RPL(3) { CTX(); const bf16_t* QKV = c.r<bf16_t>(R_QKV); bf16_t* NAO = c.r<bf16_t>(R_NAO); const float* rpb = c.in(I_NARPB);
#pragma unroll 1
              for (int u = c.vcu; u < NB * 16 * 8; u += c.G) na::na_unit(QKV, rpb, NAO, u, ldsg, c.tid, (u == c.vcu) || (c.G & 127) != 0);
            }
            GRID_BAR();
            RPL(1) { CTX(); pg8::DenseProb P{c.r<bf16_t>(R_NAO), (const bf16_t*)(ws + WS_WNAO), 2048, TL / 256, 4, c.G, c.blk};
              pg8::EpiBf16W E{c.r<bf16_t>(R_Y), 1024, 256, 128};
              pg8::gemm_phase(c.lds, P, E, c.tid); }
            GRID_BAR();
        }
        { CTX(); p_postmix_route(c, l, ntok); } GRID_BAR();
        if (STOP_AFTER == 1 + 2 * l) return;
        { CTX(); p_route_b(c, l, ntok); } GRID_BAR();
        RPL(4) { CTX(); const int nT = __builtin_amdgcn_readfirstlane((int)c.misc()[MW_NT + l]); const int* tile_e = (const int*)c.misc() + MW_TILEE + l * 2048;
          pg8::Moe1Prob P{ws + WS_H8, ws + WS_W1 + (size_t)l * 32 * 2048 * 1024, c.r<unsigned>(R_ROWTOK), tile_e, 1024, nT, c.G, c.blk};
          pg8::EpiSwiglu E{c.r<unsigned char>(R_ACT), c.in(I_B1) + (size_t)l * 32 * 2048};
          pg8::gemm_phase<pg8::Moe1Prob, pg8::EpiSwiglu, true>(c.lds, P, E, c.tid, PRB(4)); }
        GRID_BAR();
        RPL(5) { CTX(); const int nT = __builtin_amdgcn_readfirstlane((int)c.misc()[MW_NT + l]); const int* tile_e = (const int*)c.misc() + MW_TILEE + l * 2048;
          pg8::Moe2Prob P{c.r<unsigned char>(R_ACT), ws + WS_W2 + (size_t)l * 32 * 1024 * 1024, tile_e, 1024, nT, c.G, c.blk};
          pg8::EpiF8 E{c.r<unsigned char>(R_EO), 1024, c.in(I_B2) + (size_t)l * 32 * 1024, 1024};
          pg8::gemm_phase<pg8::Moe2Prob, pg8::EpiF8, true>(c.lds, P, E, c.tid, PRB(5)); }
        GRID_BAR();
        { CTX(); p_postffn(c, l, ntok, last); }
        if (STOP_AFTER == 2 + 2 * l) return;
        if (!last) GRID_BAR();
    }
#undef GRID_BAR
#undef CTX
}

extern "C" void kernel_launch(void* const* d_in, const int* in_sizes, int n_in, void* d_out, int out_size, void* d_ws, size_t ws_size, hipStream_t stream) {
    static int grid = 0;
    if (grid == 0) {
        if (n_in != 27 || out_size != TL * DM || ws_size < WS_END) { fprintf(stderr, "kernel_launch: unexpected shapes: n_in %d out %d ws %zu (need %zu)\n", n_in, out_size, ws_size, (size_t)WS_END); grid = -1; return; }
        int dev = 0, cus = 0, per_cu = 0;
        if (hipGetDevice(&dev) != hipSuccess || hipDeviceGetAttribute(&cus, hipDeviceAttributeMultiprocessorCount, dev) != hipSuccess) { grid = -1; return; }
        if (hipFuncSetAttribute((const void*)fwd_kernel, hipFuncAttributeMaxDynamicSharedMemorySize, LDS_BYTES) != hipSuccess) { fprintf(stderr, "kernel_launch: hipFuncSetAttribute failed\n"); grid = -1; return; }
        if (hipOccupancyMaxActiveBlocksPerMultiprocessor(&per_cu, (const void*)fwd_kernel, NTHREADS, LDS_BYTES) != hipSuccess || per_cu < 1) { fprintf(stderr, "kernel_launch: occupancy query says %d\n", per_cu); }
        (void)hipGetLastError();
        grid = cus;
    }
    if (grid < 0) return;
    if (hipMemsetAsync((char*)d_ws + WS_CTL, 0, CTL_ZERO_BYTES, stream) != hipSuccess) return;
    Params p{};
    for (int i = 0; i < 27; ++i) p.in[i] = (const float*)d_in[i];
    p.out = (float*)d_out; p.ws = (unsigned char*)d_ws;
    hipLaunchKernelGGL(fwd_kernel, dim3(grid), dim3(NTHREADS), LDS_BYTES, stream, p);
    const hipError_t le = hipPeekAtLastError();
    if (le != hipSuccess) fprintf(stderr, "kernel_launch: launch failed: %s\n", hipGetErrorName(le));
}
```
